# Optimizing an MI355X kernel written in HIP

```python
import math, functools
import jax, jax.numpy as jnp
from jax import lax
import numpy as np

D_MODEL = 2048
BATCH = 4
SEQ = 2048
DEPTH = 1
DEC_BATCH = 128
DEC_SEQ = 8
PAST_LEN = 16384
PAGE_SIZE = 128

GLA_HEADS = 4
GLA_DK = D_MODEL // 2 // GLA_HEADS
GLA_DV = D_MODEL // GLA_HEADS
GLA_RANK = 16
GLA_TAU = 16.0
GDN_HEADS = 16
GDN_DK = D_MODEL // GDN_HEADS
GDN_DV = D_MODEL // GDN_HEADS
CONV_W = 4
CHUNK = 64
EPS = 1e-6

GLA_QK = GLA_HEADS * GLA_DK
GLA_V = GLA_HEADS * GLA_DV
GDN_QK = GDN_HEADS * GDN_DK
GDN_V = GDN_HEADS * GDN_DV
CONV_CH = 2 * GDN_QK + GDN_V
SPLIT_SIZES = (GLA_QK, GLA_QK, GLA_V, GLA_RANK, GLA_V,
               CONV_CH, GDN_HEADS, GDN_HEADS, GDN_V,
               D_MODEL, D_MODEL)
SPLIT_POINTS = tuple(int(s) for s in np.cumsum(SPLIT_SIZES)[:-1])
D_IN = int(sum(SPLIT_SIZES))

kernel_name = "hybrid_gla_gdn_parallel_gated_step"


def _rmsnorm(x, g):
    xf = x.astype(jnp.float32)
    inv = lax.rsqrt(jnp.mean(xf * xf, axis=-1, keepdims=True) + EPS)
    return (xf * inv * g.astype(jnp.float32)).astype(x.dtype)


def _l2norm(x):
    xf = x.astype(jnp.float32)
    return xf * lax.rsqrt(jnp.sum(xf * xf, axis=-1, keepdims=True) + EPS)


def _to_chunks(a, c, n):
    t = a.shape[1]
    a = jnp.pad(a, [(0, 0), (0, n * c - t)] + [(0, 0)] * (a.ndim - 2))
    a = a.reshape((a.shape[0], n, c) + a.shape[2:])
    return jnp.moveaxis(a, 1, 0)


def _from_chunks(o, t):
    o = jnp.moveaxis(o, 0, 1)
    o = o.reshape((o.shape[0], o.shape[1] * o.shape[2]) + o.shape[3:])
    return o[:, :t]


def _gla_chunked(q, k, v, log_a, s0):
    t = q.shape[1]
    c = min(CHUNK, t)
    n = -(-t // c)
    xs = tuple(_to_chunks(a, c, n) for a in (q, k, v, log_a))
    mask = jnp.tril(jnp.ones((c, c), dtype=bool))

    def step(s, inp):
        qc, kc, vc, lac = inp
        b = jnp.cumsum(lac, axis=1)
        b_last = b[:, -1]
        q_d = qc * jnp.exp(b)
        k_d = kc * jnp.exp(-b)
        att = jnp.where(mask, jnp.einsum('bihd,bjhd->bhij', q_d, k_d), 0.0)
        o = (jnp.einsum('bhij,bjhv->bihv', att, vc)
             + jnp.einsum('bihd,bhdv->bihv', q_d, s))
        k_end = kc * jnp.exp(b_last[:, None] - b)
        s = s * jnp.exp(b_last)[..., None] + jnp.einsum('bjhd,bjhv->bhdv', k_end, vc)
        return s, o

    s, o = lax.scan(step, s0, xs)
    return _from_chunks(o, t), s


def _gdn_chunked(q, k, v, g, beta, s0):
    t = q.shape[1]
    c = min(CHUNK, t)
    n = -(-t // c)
    xs = tuple(_to_chunks(a, c, n) for a in (q, k, v, g, beta))
    incl = jnp.tril(jnp.ones((c, c), dtype=bool))
    strict = jnp.tril(jnp.ones((c, c), dtype=bool), k=-1)
    eye = jnp.eye(c, dtype=jnp.float32)

    def step(s, inp):
        qc, kc, vc, gc, bc = inp
        qh = jnp.moveaxis(qc, 1, 2)
        kh = jnp.moveaxis(kc, 1, 2)
        vh = jnp.moveaxis(vc, 1, 2)
        gh = jnp.cumsum(jnp.moveaxis(gc, 1, 2), axis=-1)
        bh = jnp.moveaxis(bc, 1, 2)
        diff = gh[..., :, None] - gh[..., None, :]
        decay = jnp.exp(jnp.where(incl, diff, -jnp.inf))
        kk = jnp.einsum('bhid,bhjd->bhij', kh, kh)
        m = jnp.where(strict, bh[..., :, None] * kk * decay, 0.0)
        rhs = jnp.concatenate([vh * bh[..., None],
                               kh * (bh * jnp.exp(gh))[..., None]], axis=-1)
        sol = lax.linalg.triangular_solve(eye + m, rhs, left_side=True, lower=True,
                                          unit_diagonal=True)
        u, w = sol[..., :GDN_DV], sol[..., GDN_DV:]
        v_new = u - jnp.einsum('bhcd,bhdv->bhcv', w, s)
        qk = jnp.einsum('bhid,bhjd->bhij', qh, kh) * decay
        o = (jnp.einsum('bhid,bhdv->bhiv', qh * jnp.exp(gh)[..., None], s)
             + jnp.einsum('bhij,bhjv->bhiv', qk, v_new))
        g_last = gh[..., -1]
        k_end = kh * jnp.exp(g_last[..., None] - gh)[..., None]
        s = s * jnp.exp(g_last)[..., None, None] + jnp.einsum('bhcd,bhcv->bhdv', k_end, v_new)
        return s, jnp.moveaxis(o, 1, 2)

    s, o = lax.scan(step, s0, xs)
    return _from_chunks(o, t), s


def _causal_conv(u, buf, w):
    t = u.shape[1]
    ext = jnp.concatenate([buf.astype(u.dtype), u], axis=1)
    out = sum(ext[:, i:i + t] * w[i] for i in range(CONV_W))
    return out, ext[:, -(CONV_W - 1):]


def _layer(x, s_gla, s_gdn, conv_buf, ln_g, w_in, w_alpha2, b_alpha, conv_w, a_log,
           dt_bias, gla_norm_g, gdn_norm_g, w_br_a, w_br_b, w_out):
    bsz, t = x.shape[0], x.shape[1]
    f32 = jnp.float32
    h = _rmsnorm(x, ln_g)
    proj = h @ w_in
    (q_a, k_a, v_a, lr_a, gate_a, qkv_b, beta_b, dec_b, gate_b, m_a, m_b) = jnp.split(
        proj, SPLIT_POINTS, axis=-1)

    q_a = q_a.reshape(bsz, t, GLA_HEADS, GLA_DK).astype(f32) * (GLA_DK ** -0.5)
    k_a = k_a.reshape(bsz, t, GLA_HEADS, GLA_DK).astype(f32)
    v_a = v_a.reshape(bsz, t, GLA_HEADS, GLA_DV).astype(f32)
    log_alpha = jax.nn.log_sigmoid((lr_a @ w_alpha2 + b_alpha).astype(f32)) / GLA_TAU
    log_alpha = log_alpha.reshape(bsz, t, GLA_HEADS, GLA_DK)
    o_a, s_gla_new = _gla_chunked(q_a, k_a, v_a, log_alpha, s_gla.astype(f32))
    o_a = _rmsnorm(o_a, gla_norm_g).reshape(bsz, t, GLA_V).astype(x.dtype) * jax.nn.silu(gate_a)
    y_a = o_a @ w_br_a

    qkv, conv_new = _causal_conv(qkv_b, conv_buf, conv_w)
    qkv = jax.nn.silu(qkv)
    q_b, k_b, v_b = jnp.split(qkv, [GDN_QK, 2 * GDN_QK], axis=-1)
    q_b = _l2norm(q_b.reshape(bsz, t, GDN_HEADS, GDN_DK)) * (GDN_DK ** -0.5)
    k_b = _l2norm(k_b.reshape(bsz, t, GDN_HEADS, GDN_DK))
    v_b = v_b.reshape(bsz, t, GDN_HEADS, GDN_DV).astype(f32)
    beta = jax.nn.sigmoid(beta_b.astype(f32))
    g = -jnp.exp(a_log.astype(f32)) * jax.nn.softplus(dec_b.astype(f32) + dt_bias.astype(f32))
    o_b, s_gdn_new = _gdn_chunked(q_b, k_b, v_b, g, beta, s_gdn.astype(f32))
    o_b = _rmsnorm(o_b, gdn_norm_g).reshape(bsz, t, GDN_V).astype(x.dtype) * jax.nn.silu(gate_b)
    y_b = o_b @ w_br_b

    merged = jax.nn.sigmoid(m_a) * y_a + jax.nn.sigmoid(m_b) * y_b
    out = x + merged @ w_out
    return out, s_gla_new.astype(x.dtype), s_gdn_new.astype(x.dtype), conv_new.astype(x.dtype)


def setup_inputs(seed: int = 0) -> dict:
    key = jax.random.key(seed)
    ks = jax.random.split(key, 20)
    f = jnp.float32
    x_prompt = jax.random.normal(ks[0], (BATCH, SEQ, D_MODEL), f)
    x_sample = jax.random.normal(ks[1], (DEC_BATCH, DEC_SEQ, D_MODEL), f)
    state_gla = jax.random.normal(ks[2], (DEPTH, DEC_BATCH, GLA_HEADS, GLA_DK, GLA_DV), f)
    state_gdn = 0.5 * jax.random.normal(ks[3], (DEPTH, DEC_BATCH, GDN_HEADS, GDN_DK, GDN_DV), f)
    state_conv = jax.random.normal(ks[4], (DEPTH, DEC_BATCH, CONV_W - 1, CONV_CH), f)
    ln_in_g = 1.0 + 0.02 * jax.random.normal(ks[5], (DEPTH, D_MODEL), f)
    w_in = jax.random.normal(ks[6], (DEPTH, D_MODEL, D_IN), f) * D_MODEL ** -0.5
    w_alpha2 = jax.random.normal(ks[7], (DEPTH, GLA_RANK, GLA_QK), f) * GLA_RANK ** -0.5
    b_alpha = 0.1 * jax.random.normal(ks[8], (DEPTH, GLA_QK), f)
    conv_w = jax.random.normal(ks[9], (DEPTH, CONV_W, CONV_CH), f) * CONV_W ** -0.5
    a_log = jnp.log(jax.random.uniform(ks[10], (DEPTH, GDN_HEADS), f, 1.0, 16.0))
    dt = jnp.exp(jax.random.uniform(ks[11], (DEPTH, GDN_HEADS), f,
                                    math.log(1e-3), math.log(1e-1)))
    dt_bias = dt + jnp.log(-jnp.expm1(-dt))
    gla_norm_g = 1.0 + 0.02 * jax.random.normal(ks[12], (DEPTH, GLA_DV), f)
    gdn_norm_g = 1.0 + 0.02 * jax.random.normal(ks[13], (DEPTH, GDN_DV), f)
    w_br_a = jax.random.normal(ks[14], (DEPTH, GLA_V, D_MODEL), f) * GLA_V ** -0.5
    w_br_b = jax.random.normal(ks[15], (DEPTH, GDN_V, D_MODEL), f) * GDN_V ** -0.5
    w_out = jax.random.normal(ks[16], (DEPTH, D_MODEL, D_MODEL), f) * D_MODEL ** -0.5
    final_norm_g = 1.0 + 0.02 * jax.random.normal(ks[17], (D_MODEL,), f)
    return {"x_prompt": x_prompt, "x_sample": x_sample,
            "state_gla": state_gla, "state_gdn": state_gdn, "state_conv": state_conv,
            "ln_in_g": ln_in_g, "w_in": w_in, "w_alpha2": w_alpha2, "b_alpha": b_alpha,
            "conv_w": conv_w, "a_log": a_log, "dt_bias": dt_bias,
            "gla_norm_g": gla_norm_g, "gdn_norm_g": gdn_norm_g,
            "w_br_a": w_br_a, "w_br_b": w_br_b, "w_out": w_out,
            "final_norm_g": final_norm_g}


def reference(x_prompt, x_sample, state_gla, state_gdn, state_conv, ln_in_g, w_in, w_alpha2,
              b_alpha, conv_w, a_log, dt_bias, gla_norm_g, gdn_norm_g, w_br_a, w_br_b, w_out,
              final_norm_g):
    bp = x_prompt.shape[0]
    dt_ = x_prompt.dtype
    hp, hs = x_prompt, x_sample
    gla_p, gdn_p, conv_p, gla_s, gdn_s, conv_s = [], [], [], [], [], []
    for l in range(DEPTH):
        params = (ln_in_g[l], w_in[l], w_alpha2[l], b_alpha[l], conv_w[l], a_log[l], dt_bias[l],
                  gla_norm_g[l], gdn_norm_g[l], w_br_a[l], w_br_b[l], w_out[l])
        z_gla = jnp.zeros((bp, GLA_HEADS, GLA_DK, GLA_DV), dt_)
        z_gdn = jnp.zeros((bp, GDN_HEADS, GDN_DK, GDN_DV), dt_)
        z_conv = jnp.zeros((bp, CONV_W - 1, CONV_CH), dt_)
        hp, sg, sd, sc = _layer(hp, z_gla, z_gdn, z_conv, *params)
        gla_p.append(sg); gdn_p.append(sd); conv_p.append(sc)
        hs, sg, sd, sc = _layer(hs, state_gla[l], state_gdn[l], state_conv[l], *params)
        gla_s.append(sg); gdn_s.append(sd); conv_s.append(sc)
    y_prompt = _rmsnorm(hp, final_norm_g)
    y_sample = _rmsnorm(hs, final_norm_g)
    new_gla_prompt = jnp.stack(gla_p)
    new_gdn_prompt = jnp.stack(gdn_p)
    new_conv_prompt = jnp.stack(conv_p)
    new_gla_sample = jnp.stack(gla_s)
    new_gdn_sample = jnp.stack(gdn_s)
    new_conv_sample = jnp.stack(conv_s)
    return (y_prompt, y_sample, new_gla_prompt, new_gdn_prompt, new_conv_prompt,
            new_gla_sample, new_gdn_sample, new_conv_sample)
```

```cpp
#include <hip/hip_runtime.h>
#include <hip/hip_cooperative_groups.h>
#include <cstdio>
#include <cstdint>
namespace cg = cooperative_groups;

#define LAS __attribute__((address_space(3)))
typedef unsigned short bf16_t;
typedef unsigned int u32;
typedef short bf16x8 __attribute__((ext_vector_type(8)));
typedef float f32x4 __attribute__((ext_vector_type(4)));
typedef float f32x2 __attribute__((ext_vector_type(2)));
typedef u32 u32x4 __attribute__((ext_vector_type(4)));
typedef u32 u32x2 __attribute__((ext_vector_type(2)));

constexpr int D = 2048, NTP = 8192, NTS = 1024, NT = NTP + NTS, SEQ = 2048, DSEQ = 8;
constexpr int DIN = 18480, N1 = 18688;
constexpr int C_QA = 0, C_KA = 1024, C_VA = 2048, C_GA = 4096, C_QKVB = 6144, C_GB = 12288, C_MA = 14336, C_MB = 16384, C_LR = 18432, C_BETA = 18448, C_DEC = 18464;
constexpr float EPS = 1e-6f;
constexpr size_t O_Y = 0, O_GLA_P = 18874368, O_GDN_P = 20971520, O_CONV_P = 22020096, O_GLA_S = 22093824, O_GDN_S = 89202688, O_CONV_S = 122757120;
constexpr size_t WS_H = 0, WS_W1T = WS_H + (size_t)NT * D * 2, WS_WAT = WS_W1T + (size_t)N1 * D * 2, WS_WBT = WS_WAT + (size_t)D * D * 2, WS_WOT = WS_WBT + (size_t)D * D * 2,
                 WS_P = WS_WOT + (size_t)D * D * 2, WS_ALPHA = WS_P + (size_t)NT * N1 * 2, WS_QB = WS_ALPHA + (size_t)NT * 1024 * 4, WS_KB = WS_QB + (size_t)NT * D * 4,
                 WS_VB = WS_KB + (size_t)NT * D * 4, WS_BETA = WS_VB + (size_t)NT * D * 4, WS_GA = WS_BETA + (size_t)NT * 16 * 4, WS_OA = WS_GA + (size_t)NT * 16 * 4,
                 WS_OB = WS_OA + (size_t)NT * D * 4, WS_ATT = WS_OB + (size_t)NT * D * 4, WS_E = WS_ATT + (size_t)512 * 4096 * 2, WS_GQKM = WS_E + (size_t)512 * 256 * 4, WS_GU = WS_GQKM + (size_t)2048 * 4096 * 2, WS_GT = WS_GU + (size_t)2048 * 8192 * 4, WS_GEG = WS_GT + (size_t)2048 * 4096 * 4, WS_BAR = WS_GEG + (size_t)2048 * 4, WS_GL = WS_BAR + (size_t)65536, WS_END = WS_GL + (size_t)NT * 16 * 4;
constexpr size_t WS_GW = WS_H, WS_GQG = WS_GW + (size_t)2048 * 8192 * 2, WS_GKE = WS_GQG + (size_t)2048 * 8192 * 2;
static_assert(WS_GKE + (size_t)2048 * 8192 * 2 <= WS_WAT, "overlay3");
constexpr size_t WS_QD = WS_ALPHA, WS_KET = WS_QD + (size_t)512 * 16384 * 2;
static_assert(WS_KET + (size_t)512 * 16384 * 2 <= WS_ALPHA + (size_t)NTP * 1024 * 4, "overlay2");
constexpr size_t WS_OAN = WS_H, WS_OBN = WS_OAN + (size_t)NT * D * 2, WS_MRG = WS_OBN + (size_t)NT * D * 2, WS_YT = WS_QB;
static_assert(WS_MRG + (size_t)NT * D * 2 <= WS_WAT, "overlay");
constexpr int LDS_BYTES = 131072 + 64;

struct Params {
    const float *x_prompt, *x_sample, *state_gla, *state_gdn, *state_conv, *ln_in_g, *w_in, *w_alpha2, *b_alpha, *conv_w, *a_log, *dt_bias, *gla_norm_g, *gdn_norm_g, *w_br_a, *w_br_b, *w_out, *final_norm_g;
    float* out;
    unsigned char* ws;
};

__device__ __forceinline__ u32 cvt_pk_bf16(float lo, float hi) { u32 r; asm volatile("v_cvt_pk_bf16_f32 %0, %1, %2" : "=v"(r) : "v"(lo), "v"(hi)); return r; }
__device__ __forceinline__ float bf_lo(u32 w) { return __uint_as_float(w << 16); }
__device__ __forceinline__ float bf_hi(u32 w) { return __uint_as_float(w & 0xffff0000u); }
__device__ __forceinline__ float bf1(bf16_t h) { return __uint_as_float(((u32)h) << 16); }
__device__ __forceinline__ float wave_sum(float v) {
#pragma unroll
    for (int o = 1; o < 64; o <<= 1) v += __shfl_xor(v, o);
    return v;
}
template <int CTRL> __device__ __forceinline__ float dpp(float x) { return __builtin_bit_cast(float, __builtin_amdgcn_mov_dpp(__builtin_bit_cast(int, x), CTRL, 0xf, 0xf, true)); }
constexpr int ROR8 = 0x128, ROR4 = 0x124;
__device__ __forceinline__ float xrow16_sum(float x) {
    auto s = __builtin_amdgcn_permlane16_swap(__float_as_uint(x), __float_as_uint(x), false, false);
    x = __uint_as_float(s[0]) + __uint_as_float(s[1]);
    auto t = __builtin_amdgcn_permlane32_swap(__float_as_uint(x), __float_as_uint(x), false, false);
    return __uint_as_float(t[0]) + __uint_as_float(t[1]);
}
__device__ __forceinline__ float wave_sum_fast(float x) {
    x += dpp<0xB1>(x); x += dpp<0x4E>(x); x += dpp<0x141>(x); x += dpp<0x140>(x);
    return xrow16_sum(x);
}
__device__ __forceinline__ float sigmoidf_(float x) { return __builtin_amdgcn_rcpf(1.0f + __expf(-x)); }
__device__ __forceinline__ float siluf_(float x) { return x * sigmoidf_(x); }
__device__ __forceinline__ float softplusf_(float x) { return fmaxf(x, 0.f) + log1pf(expf(-fabsf(x))); }
__device__ __forceinline__ int otid() { int t = threadIdx.x; asm volatile("" : "+v"(t)); return t; }
__device__ __forceinline__ void lds_barrier() { asm volatile("s_waitcnt lgkmcnt(0)" ::: "memory"); __builtin_amdgcn_s_barrier(); asm volatile("" ::: "memory"); }
#define LDS_WAIT() asm volatile("s_waitcnt lgkmcnt(0)" ::: "memory")

#define XB_TMO      128
#define XB_XCNT(j)  (256  + 64 * (j))
#define XB_XSUB(j)  (1280 + 64 * (j))
#define XB_XGEN(j)  (2304 + 64 * (j))
#define XB_TOP      3328
#define XB_TOPGEN   3392
#define XCD_BAR_WORDS 3456
#define XB_SPIN_CAP (1u << 18)
__device__ __forceinline__ unsigned xb_ld(unsigned* p)              { return __hip_atomic_load(p, __ATOMIC_RELAXED, __HIP_MEMORY_SCOPE_AGENT); }
__device__ __forceinline__ unsigned xb_add(unsigned* p, unsigned v) { return __hip_atomic_fetch_add(p, v, __ATOMIC_RELAXED, __HIP_MEMORY_SCOPE_AGENT); }
__device__ __forceinline__ unsigned xb_xcc_id() { return (unsigned)__builtin_amdgcn_s_getreg((3 << 11) | 20) & 0xFu; }
#define XB_SPIN(cond, bar) do { unsigned _sp = 0; while (cond) { __builtin_amdgcn_s_sleep(1); \
    if ((++_sp & 255u) == 0u) { if (xb_ld(&(bar)[XB_TMO])) break; if (_sp > XB_SPIN_CAP) { atomicAdd(&(bar)[XB_TMO], 1u); break; } } } } while (0)
struct XcdBarrier { unsigned* bar; unsigned x; volatile LAS unsigned* st; };
__device__ __forceinline__ XcdBarrier xcd_barrier_post(unsigned* bar, volatile LAS unsigned* st) {
    XcdBarrier b; b.bar = bar; b.x = xb_xcc_id(); b.st = st;
    if (threadIdx.x == 0) (void)xb_add(&bar[XB_XCNT(b.x)], 1u);
    return b;
}
__device__ __forceinline__ void xcd_barrier_complete(unsigned* bar, unsigned x, unsigned& nloc, unsigned& nx) {
    const unsigned G = gridDim.x * gridDim.y * gridDim.z;
    unsigned sum, cnt, mine, sp = 0u;
    for (;;) {
        sum = 0u; cnt = 0u; mine = 0u;
#pragma unroll
        for (unsigned j = 0; j < 16; ++j) { const unsigned c = xb_ld(&bar[XB_XCNT(j)]); sum += c; cnt += (c > 0u) ? 1u : 0u; mine = (j == x) ? c : mine; }
        if (sum == G) break;
        __builtin_amdgcn_s_sleep(1);
        if ((++sp & 255u) == 0u) { if (xb_ld(&bar[XB_TMO])) break; if (sp > XB_SPIN_CAP) { atomicAdd(&bar[XB_TMO], 1u); break; } }
    }
    nloc = mine > 0u ? mine : 1u; nx = cnt > 0u ? cnt : 1u;
}
__device__ __forceinline__ void xcd_barrier(const XcdBarrier& b) {
    asm volatile("s_waitcnt vmcnt(0)" ::: "memory");
    __syncthreads();
    if (threadIdx.x == 0) {
        unsigned* bar = b.bar;
        __builtin_amdgcn_s_waitcnt(0);
        unsigned nloc = b.st[0], nx = b.st[1];
        if (nloc == 0u) { xcd_barrier_complete(bar, b.x, nloc, nx); b.st[0] = nloc; b.st[1] = nx; }
        const unsigned old = xb_add(&bar[XB_XSUB(b.x)], 1u);
        const unsigned gen = old / nloc;
        if (old + 1u == (gen + 1u) * nloc) {
            __builtin_amdgcn_fence(__ATOMIC_RELEASE, "agent");
            asm volatile("s_waitcnt vmcnt(0)" ::: "memory");
            const unsigned og = xb_add(&bar[XB_TOP], 1u);
            const unsigned tg = og / nx;
            if (og + 1u == (tg + 1u) * nx) xb_add(&bar[XB_TOPGEN], 1u);
            else XB_SPIN(xb_ld(&bar[XB_TOPGEN]) == tg, bar);
            __builtin_amdgcn_fence(__ATOMIC_ACQUIRE, "agent");
            xb_add(&bar[XB_XGEN(b.x)], 1u);
            asm volatile("s_waitcnt vmcnt(0)" ::: "memory");
        } else {
            XB_SPIN(xb_ld(&bar[XB_XGEN(b.x)]) == gen, bar);
            __builtin_amdgcn_fence(__ATOMIC_ACQUIRE, "agent");
            asm volatile("s_waitcnt vmcnt(0)" ::: "memory");
        }
    }
    __syncthreads();
}

namespace pg8 {
constexpr int BM = 256, BK = 64, HALF = 128, HTB = HALF * BK * 2, STAGE_BYTES = 8 * HTB, NXCD = 8, WGM = 8;
__device__ __forceinline__ int lds_byte(int r, int c) { const int st = (r >> 4) * 2 + (c >> 5), rr = r & 15, cc = c & 31, ob = rr * 64 + cc * 2; return st * 1024 + (ob ^ (((ob >> 9) & 1) << 5)); }
__device__ __forceinline__ void stage_rc(int b, int& R, int& C) { const int st = b / 1024, sb = b % 1024, swz = sb ^ (((sb >> 9) & 1) << 5); R = (st >> 1) * 16 + swz / 64; C = (st & 1) * 32 + (swz % 64) / 2; }
__device__ __forceinline__ int perm32(int rho) { const int n = rho >> 4, i = rho & 15; return 8 * (i >> 2) + 4 * n + (i & 3); }
struct Unit { int pm, pn, w, t; };
struct Gemm { const bf16_t *A0, *A1, *Bt0, *Bt1; int M, N, K; };
struct StaticOrder {
    int nM, nN, nwg, G, c;
    __device__ void init(int M, int N, int G_, int c_) { nM = M / BM; nN = N / BM; nwg = nM * nN; G = G_; c = c_; }
    __device__ bool next(int i, Unit& u) const { const long L = (long)i * G + c; if (L >= nwg) return false; map((int)L, u); return true; }
    __device__ void map(int L, Unit& u) const {
        int wgid = L; { const int q = nwg / NXCD, r = nwg % NXCD, xcd = wgid % NXCD, off = wgid / NXCD; wgid = (xcd < r ? xcd * (q + 1) : r * (q + 1) + (xcd - r) * q) + off; }
        const int nig = WGM * nN, gid = wgid / nig, fm = gid * WGM, gsz = (nM - fm) < WGM ? (nM - fm) : WGM;
        u.pm = fm + ((wgid % nig) % gsz); u.pn = (wgid % nig) / gsz; u.w = 0; u.t = 0;
    }
};
struct PairOrder : StaticOrder {
    __device__ bool next(int i, Unit& u) const {
        if (G != 256 || nwg != 288) { const bool ok = StaticOrder::next(i >> 1, u); u.w = i & 1; return ok; }
        if (i < 2) { map(c, u); u.w = i; return true; }
        if (i == 2 && c < 64) { const int t = c & 31; map(256 + t, u); u.w = 2 + (c >> 5); u.t = t; return true; }
        return false;
    }
};

template <bool SP2, bool ALIGN_EPI, class Epi, class Sched>
__device__ __forceinline__ void gemm_phase(LAS unsigned char* lds, const Gemm g, const Sched& S, const Epi& E) {
    const int tid = otid(), wid = __builtin_amdgcn_readfirstlane(tid >> 6), lane = tid & 63, wr = wid >> 2, wc = wid & 3, fr = lane & 15, fq = lane >> 4;
    const int K = g.K, nt = K / BK;
    unsigned voffA[2], voffB[2];
#pragma unroll
    for (int i = 0; i < 2; ++i) { int R, C; stage_rc(tid * 16 + i * 8192, R, C); const int Rb = Epi::PERM ? ((R & ~31) + perm32(R & 31)) : R;
        voffA[i] = (unsigned)(R * K + C) * 2u; voffB[i] = (unsigned)(Rb * K + C) * 2u; }
    const size_t kstep = (size_t)(BK * 2);
    const size_t hstep = (size_t)HALF * K * 2;
    const size_t tstep = 2 * hstep;
    const unsigned ldsw = (unsigned)wid * 1024u;
    const int aoff = lds_byte(wr * 64 + fr, fq * 8), boff = lds_byte(wc * 32 + fr, fq * 8);
#define PG8_SA(b, h) (((b) * 2 + (h)) * HTB)
#define PG8_SB(b, h) ((4 + (b) * 2 + (h)) * HTB)
#define PG8_STAGE(bufoff, gbase, voff) do { _Pragma("unroll") for (int _i = 0; _i < 2; ++_i) \
        __builtin_amdgcn_global_load_lds((const unsigned*)((const char*)(gbase) + (voff)[_i]), (LAS unsigned*)(lds + (bufoff) + ldsw + _i * 8192), 16, 0, 0); } while (0)
#define PG8_LDA(dst, b, h) do { _Pragma("unroll") for (int m = 0; m < 4; ++m) _Pragma("unroll") for (int k = 0; k < 2; ++k) dst[m][k] = *(const LAS bf16x8*)(lds + PG8_SA(b, h) + aoff + m * 2048 + k * 1024); } while (0)
#define PG8_LDB(dst, b, h) do { _Pragma("unroll") for (int n = 0; n < 2; ++n) _Pragma("unroll") for (int k = 0; k < 2; ++k) dst[n][k] = *(const LAS bf16x8*)(lds + PG8_SB(b, h) + boff + n * 2048 + k * 1024); } while (0)
#define PG8_MMA(ai, bj, At, Bt) do { __builtin_amdgcn_s_setprio(1); _Pragma("unroll") for (int m = 0; m < 4; ++m) _Pragma("unroll") for (int n = 0; n < 2; ++n) _Pragma("unroll") for (int k = 0; k < 2; ++k) \
        acc[ai][bj][m][n] = __builtin_amdgcn_mfma_f32_16x16x32_bf16(Bt[n][k], At[m][k], acc[ai][bj][m][n], 0, 0, 0); __builtin_amdgcn_s_setprio(0); } while (0)
#define PG8_WAIT_V(n) asm volatile("s_waitcnt vmcnt(" #n ")" ::: "memory")
#define PG8_WAIT_L(n) asm volatile("s_waitcnt lgkmcnt(" #n ")" ::: "memory")
#define PG8_BAR __builtin_amdgcn_s_barrier()
#define PG8_SCHED __builtin_amdgcn_sched_barrier(0)
    Unit cur, nxt; int ui = 0;
    if (!S.next(0, cur)) return;
    f32x4 acc[2][2][4][2];
#pragma unroll
    for (int a = 0; a < 2; ++a)
#pragma unroll
        for (int b = 0; b < 2; ++b)
#pragma unroll
            for (int m = 0; m < 4; ++m)
#pragma unroll
                for (int n = 0; n < 2; ++n) acc[a][b][m][n] = (f32x4){0.f, 0.f, 0.f, 0.f};
    bf16x8 At[4][2], B0[2][2], B1[2][2];
    const char* cA = (const char*)((cur.w & 1) ? g.A1 : g.A0) + (size_t)cur.pm * tstep; const char* cB = (const char*)((cur.w & 1) ? g.Bt1 : g.Bt0) + (size_t)cur.pn * tstep;
    if constexpr (SP2) {
        PG8_STAGE(PG8_SB(0, 0), cB, voffB); PG8_STAGE(PG8_SB(0, 1), cB + hstep, voffB); PG8_STAGE(PG8_SA(0, 0), cA, voffA); PG8_STAGE(PG8_SA(0, 1), cA + hstep, voffA);
        if (wr == 1) PG8_BAR;
        PG8_WAIT_V(2); PG8_BAR;
        PG8_STAGE(PG8_SB(1, 0), cB + kstep, voffB); PG8_STAGE(PG8_SA(1, 0), cA + kstep, voffA); PG8_STAGE(PG8_SB(1, 1), cB + hstep + kstep, voffB);
        PG8_WAIT_V(6); PG8_BAR;
    } else {
    PG8_STAGE(PG8_SB(0, 0), cB, voffB); PG8_STAGE(PG8_SA(0, 0), cA, voffA); PG8_STAGE(PG8_SB(0, 1), cB + hstep, voffB); PG8_STAGE(PG8_SA(0, 1), cA + hstep, voffA);
    if (wr == 1) PG8_BAR;
    PG8_WAIT_V(4); PG8_BAR;
    PG8_STAGE(PG8_SB(1, 0), cB + kstep, voffB); PG8_STAGE(PG8_SA(1, 0), cA + kstep, voffA); PG8_STAGE(PG8_SB(1, 1), cB + hstep + kstep, voffB);
    PG8_WAIT_V(6); PG8_BAR;
    }
    for (;;) {
        const bool has_next = S.next(ui + 1, nxt);
        const char* nA = has_next ? (const char*)((nxt.w & 1) ? g.A1 : g.A0) + (size_t)nxt.pm * tstep : cA; const char* nB = has_next ? (const char*)((nxt.w & 1) ? g.Bt1 : g.Bt0) + (size_t)nxt.pn * tstep : cB;
        for (int t = 0; t < nt; t += 2) {
            const bool last = (t == nt - 2);
            const char* a1 = cA + (size_t)(t + 1) * kstep;
            const char* a2 = last ? nA : cA + (size_t)(t + 2) * kstep; const char* b2 = last ? nB : cB + (size_t)(t + 2) * kstep;
            const char* a3 = a2 + kstep; const char* b3 = b2 + kstep;
            if constexpr (SP2) {
            PG8_LDB(B0, 0, 0); PG8_LDB(B1, 0, 1); PG8_SCHED; PG8_LDA(At, 0, 0); PG8_STAGE(PG8_SA(1, 1), a1 + hstep, voffA);
            PG8_WAIT_V(8); PG8_WAIT_L(0); PG8_BAR; PG8_MMA(0, 0, At, B0); PG8_MMA(0, 1, At, B1); PG8_BAR; PG8_SCHED;
            PG8_LDA(At, 0, 1); PG8_STAGE(PG8_SB(0, 0), b2, voffB); PG8_STAGE(PG8_SB(0, 1), b2 + hstep, voffB); PG8_STAGE(PG8_SA(0, 0), a2, voffA);
            PG8_WAIT_V(8); PG8_WAIT_L(0); PG8_BAR; PG8_MMA(1, 0, At, B0); PG8_MMA(1, 1, At, B1); PG8_BAR; PG8_SCHED;
            PG8_LDB(B0, 1, 0); PG8_LDB(B1, 1, 1); PG8_SCHED; PG8_LDA(At, 1, 0); PG8_STAGE(PG8_SA(0, 1), a2 + hstep, voffA);
            PG8_WAIT_V(8); PG8_WAIT_L(0); PG8_BAR; PG8_MMA(0, 0, At, B0); PG8_MMA(0, 1, At, B1); PG8_BAR; PG8_SCHED;
            PG8_LDA(At, 1, 1); PG8_STAGE(PG8_SB(1, 0), b3, voffB); PG8_STAGE(PG8_SB(1, 1), b3 + hstep, voffB); PG8_STAGE(PG8_SA(1, 0), a3, voffA);
            PG8_WAIT_V(8); PG8_WAIT_L(0); PG8_BAR; PG8_MMA(1, 0, At, B0); PG8_MMA(1, 1, At, B1); PG8_BAR; PG8_SCHED;
            } else {
            PG8_LDB(B0, 0, 0); PG8_SCHED; PG8_LDA(At, 0, 0); PG8_STAGE(PG8_SA(1, 1), a1 + hstep, voffA);
            PG8_WAIT_L(8); PG8_BAR; PG8_WAIT_L(0); PG8_MMA(0, 0, At, B0); PG8_BAR; PG8_SCHED;
            PG8_LDB(B1, 0, 1); PG8_STAGE(PG8_SB(0, 0), b2, voffB);
            PG8_BAR; PG8_WAIT_L(0); PG8_MMA(0, 1, At, B1); PG8_BAR;
            PG8_LDA(At, 0, 1); PG8_STAGE(PG8_SA(0, 0), a2, voffA);
            PG8_BAR; PG8_WAIT_L(0); PG8_MMA(1, 0, At, B0); PG8_BAR; PG8_SCHED;
            PG8_STAGE(PG8_SB(0, 1), b2 + hstep, voffB);
            PG8_WAIT_V(6); PG8_BAR; PG8_MMA(1, 1, At, B1); PG8_BAR;
            PG8_LDB(B0, 1, 0); PG8_SCHED; PG8_LDA(At, 1, 0); PG8_STAGE(PG8_SA(0, 1), a2 + hstep, voffA);
            PG8_WAIT_L(8); PG8_BAR; PG8_WAIT_L(0); PG8_MMA(0, 0, At, B0); PG8_BAR; PG8_SCHED;
            PG8_LDB(B1, 1, 1); PG8_STAGE(PG8_SB(1, 0), b3, voffB);
            PG8_BAR; PG8_WAIT_L(0); PG8_MMA(0, 1, At, B1); PG8_BAR;
            PG8_LDA(At, 1, 1); PG8_STAGE(PG8_SA(1, 0), a3, voffA);
            PG8_BAR; PG8_WAIT_L(0); PG8_MMA(1, 0, At, B0); PG8_BAR; PG8_SCHED;
            PG8_STAGE(PG8_SB(1, 1), b3 + hstep, voffB);
            PG8_WAIT_V(6); PG8_BAR; PG8_MMA(1, 1, At, B1); PG8_BAR;
            }
        }
        if constexpr (ALIGN_EPI) { if (wr == 0) PG8_BAR; }
        E(acc, cur, wr, wc, fr, fq);
        if (!has_next) break;
#pragma unroll
        for (int a = 0; a < 2; ++a)
#pragma unroll
            for (int b = 0; b < 2; ++b)
#pragma unroll
                for (int m = 0; m < 4; ++m)
#pragma unroll
                    for (int n = 0; n < 2; ++n) acc[a][b][m][n] = (f32x4){0.f, 0.f, 0.f, 0.f};
        cur = nxt; cA = nA; cB = nB; ++ui;
        if constexpr (ALIGN_EPI) { if (wr == 1) PG8_BAR; }
    }
    PG8_WAIT_V(0);
    if constexpr (!ALIGN_EPI) { if (wr == 0) PG8_BAR; }
    PG8_BAR;
#undef PG8_SA
#undef PG8_SB
#undef PG8_STAGE
#undef PG8_LDA
#undef PG8_LDB
#undef PG8_MMA
#undef PG8_WAIT_V
#undef PG8_WAIT_L
#undef PG8_BAR
#undef PG8_SCHED
}

struct EpiP {
    static constexpr bool PERM = true;
    bf16_t* O;
    __device__ __forceinline__ void operator()(const f32x4 (&acc)[2][2][4][2], const Unit& u, int wr, int wc, int fr, int fq) const {
        const int row0 = u.pm * BM + wr * 64 + fr, col0 = u.pn * BM + wc * 32 + 8 * fq;
#pragma unroll
        for (int ai = 0; ai < 2; ++ai)
#pragma unroll
            for (int m = 0; m < 4; ++m) { bf16_t* rowp = O + (size_t)(row0 + ai * HALF + m * 16) * N1 + col0;
#pragma unroll
                for (int bj = 0; bj < 2; ++bj) { const f32x4 v0 = acc[ai][bj][m][0], v1 = acc[ai][bj][m][1];
                    u32x4 w; w.x = cvt_pk_bf16(v0[0], v0[1]); w.y = cvt_pk_bf16(v0[2], v0[3]); w.z = cvt_pk_bf16(v1[0], v1[1]); w.w = cvt_pk_bf16(v1[2], v1[3]);
                    *(u32x4*)(rowp + bj * HALF) = w; } }
    }
};
struct EpiGate {
    static constexpr bool PERM = true;
    const bf16_t* P; float* YT; bf16_t* MRG; unsigned* flags;
    __device__ __forceinline__ void operator()(const f32x4 (&acc)[2][2][4][2], const Unit& u, int wr, int wc, int fr, int fq) const {
        const int row0 = u.pm * BM + wr * 64 + fr, col0 = u.pn * BM + wc * 32 + 8 * fq;
        const bool isb = (u.w & 1) != 0, remote = u.w >= 2;
        const int gcol = (isb ? C_MB : C_MA) + col0;
        unsigned* flag = flags + (size_t)((u.t * 8 + wr * 4 + wc) * 16);
        if (remote && isb) {
            unsigned spins = 0;
            while ((unsigned)__builtin_amdgcn_readfirstlane(__hip_atomic_load(flag, __ATOMIC_RELAXED, __HIP_MEMORY_SCOPE_AGENT)) == 0u) { __builtin_amdgcn_s_sleep(1); if (++spins > (1u << 16)) break; }
            __builtin_amdgcn_fence(__ATOMIC_ACQUIRE, "agent");
        }
#pragma unroll
        for (int ai = 0; ai < 2; ++ai)
#pragma unroll
            for (int m = 0; m < 4; ++m) { const size_t row = (size_t)(row0 + ai * HALF + m * 16);
#pragma unroll
                for (int bj = 0; bj < 2; ++bj) {
                    const u32x4 gw = *(const u32x4*)(P + row * N1 + gcol + bj * HALF);
                    f32x4 g0, g1;
                    g0[0] = sigmoidf_(bf_lo(gw.x)); g0[1] = sigmoidf_(bf_hi(gw.x)); g0[2] = sigmoidf_(bf_lo(gw.y)); g0[3] = sigmoidf_(bf_hi(gw.y));
                    g1[0] = sigmoidf_(bf_lo(gw.z)); g1[1] = sigmoidf_(bf_hi(gw.z)); g1[2] = sigmoidf_(bf_lo(gw.w)); g1[3] = sigmoidf_(bf_hi(gw.w));
                    f32x4 v0 = acc[ai][bj][m][0] * g0, v1 = acc[ai][bj][m][1] * g1;
                    float* yp = YT + row * D + col0 + bj * HALF;
                    if (!isb) {
                        if (!remote) { *(f32x4*)yp = v0; *(f32x4*)(yp + 4) = v1; }
                        else { unsigned long long* y8 = (unsigned long long*)yp;
                            __hip_atomic_store(y8 + 0, (unsigned long long)__float_as_uint(v0[0]) | ((unsigned long long)__float_as_uint(v0[1]) << 32), __ATOMIC_RELAXED, __HIP_MEMORY_SCOPE_AGENT);
                            __hip_atomic_store(y8 + 1, (unsigned long long)__float_as_uint(v0[2]) | ((unsigned long long)__float_as_uint(v0[3]) << 32), __ATOMIC_RELAXED, __HIP_MEMORY_SCOPE_AGENT);
                            __hip_atomic_store(y8 + 2, (unsigned long long)__float_as_uint(v1[0]) | ((unsigned long long)__float_as_uint(v1[1]) << 32), __ATOMIC_RELAXED, __HIP_MEMORY_SCOPE_AGENT);
                            __hip_atomic_store(y8 + 3, (unsigned long long)__float_as_uint(v1[2]) | ((unsigned long long)__float_as_uint(v1[3]) << 32), __ATOMIC_RELAXED, __HIP_MEMORY_SCOPE_AGENT); }
                    } else {
                        if (!remote) { v0 += *(const f32x4*)yp; v1 += *(const f32x4*)(yp + 4); }
                        else { unsigned long long* y8 = (unsigned long long*)yp;
                            const unsigned long long a0 = __hip_atomic_load(y8 + 0, __ATOMIC_RELAXED, __HIP_MEMORY_SCOPE_AGENT), a1 = __hip_atomic_load(y8 + 1, __ATOMIC_RELAXED, __HIP_MEMORY_SCOPE_AGENT),
                                                     a2 = __hip_atomic_load(y8 + 2, __ATOMIC_RELAXED, __HIP_MEMORY_SCOPE_AGENT), a3 = __hip_atomic_load(y8 + 3, __ATOMIC_RELAXED, __HIP_MEMORY_SCOPE_AGENT);
                            v0 += (f32x4){__uint_as_float((unsigned)a0), __uint_as_float((unsigned)(a0 >> 32)), __uint_as_float((unsigned)a1), __uint_as_float((unsigned)(a1 >> 32))};
                            v1 += (f32x4){__uint_as_float((unsigned)a2), __uint_as_float((unsigned)(a2 >> 32)), __uint_as_float((unsigned)a3), __uint_as_float((unsigned)(a3 >> 32))}; }
                        u32x4 w; w.x = cvt_pk_bf16(v0[0], v0[1]); w.y = cvt_pk_bf16(v0[2], v0[3]); w.z = cvt_pk_bf16(v1[0], v1[1]); w.w = cvt_pk_bf16(v1[2], v1[3]);
                        *(u32x4*)(MRG + row * D + col0 + bj * HALF) = w; } } }
        if (remote && !isb) {
            asm volatile("s_waitcnt vmcnt(0)" ::: "memory");
            if (fr == 0 && fq == 0) __hip_atomic_store(flag, 1u, __ATOMIC_RELAXED, __HIP_MEMORY_SCOPE_AGENT);
        }
    }
};
struct EpiOut {
    static constexpr bool PERM = false;
    const float *xp, *xs; float* O;
    __device__ __forceinline__ void operator()(const f32x4 (&acc)[2][2][4][2], const Unit& u, int wr, int wc, int fr, int fq) const {
        const int row0 = u.pm * BM + wr * 64 + fr, col0 = u.pn * BM + wc * 32 + 4 * fq;
#pragma unroll
        for (int ai = 0; ai < 2; ++ai)
#pragma unroll
            for (int m = 0; m < 4; ++m) { const int row = row0 + ai * HALF + m * 16;
                const float* xr = (row < NTP ? xp + (size_t)row * D : xs + (size_t)(row - NTP) * D) + col0; float* rowp = O + (size_t)row * D + col0;
#pragma unroll
                for (int bj = 0; bj < 2; ++bj)
#pragma unroll
                    for (int n = 0; n < 2; ++n) *(f32x4*)(rowp + bj * HALF + n * 16) = acc[ai][bj][m][n] + __builtin_nontemporal_load((const f32x4*)(xr + bj * HALF + n * 16)); }
    }
};
}

__device__ __forceinline__ int srccol(int n) {
    if (n < 4096) return n;
    if (n < 12288) return n + 16;
    if (n < 18432) return n + 48;
    if (n < 18448) return 4096 + (n - 18432);
    if (n < 18464) return 12304 + (n - 18448);
    if (n < 18480) return 12320 + (n - 18464);
    return -1;
}
__device__ __forceinline__ void phase0(const Params& p, LAS unsigned char* lds) {
    const int tid_ = otid(), lane = tid_ & 63, wave = tid_ >> 6;
    const int gw = blockIdx.x * 8 + wave, NGW = gridDim.x * 8;
    LAS float* scr = (LAS float*)(lds + wave * 16384);
    bf16_t* W1T = (bf16_t*)(p.ws + WS_W1T); bf16_t* WAT = (bf16_t*)(p.ws + WS_WAT); bf16_t* WBT = (bf16_t*)(p.ws + WS_WBT); bf16_t* WOT = (bf16_t*)(p.ws + WS_WOT);
    constexpr int I1 = 32 * (N1 / 32), I2 = 32 * 64, NI = I1 + 3 * I2;
    struct TI { const float* W; bf16_t* WT; int ldw, k0, n0, sc; };
    const float* w_a = p.w_br_a; const float* w_b = p.w_br_b; const float* w_o = p.w_out; const float* w_i = p.w_in;
    asm volatile("" : "+s"(w_a), "+s"(w_b), "+s"(w_o), "+s"(w_i));
    auto decode = [&](int it, TI& t) __attribute__((always_inline)) {
        int r = it; bool map = false;
        if (r < I1) { t.W = w_i; t.WT = W1T; t.ldw = DIN; t.k0 = 64 * (r / (N1 / 32)); t.n0 = 32 * (r % (N1 / 32)); map = true; }
        else { r -= I1; const int m = r / I2; r -= m * I2; t.W = (const float*)((uintptr_t)w_a + (m == 1 ? (uintptr_t)w_b - (uintptr_t)w_a : (uintptr_t)0) + (m == 2 ? (uintptr_t)w_o - (uintptr_t)w_a : (uintptr_t)0)); t.WT = WAT + (size_t)m * D * D;   t.ldw = D; t.k0 = 64 * (r / 64); t.n0 = 32 * (r % 64); }
        const int c = t.n0 + (lane & 31); t.sc = map ? srccol(c) : c;
    };
    if (gw < NI) {
        struct V8 { f32x4 a, b, c, d, e, f, g, h; };
        TI ta, tb; V8 va, vb;
        auto ld1 = [&](const TI& t, int i) __attribute__((always_inline)) -> float { const int kk = 2 * i + (lane >> 5); return t.sc >= 0 ? __builtin_nontemporal_load(t.W + (size_t)(t.k0 + kk) * t.ldw + t.sc) : 0.f; };
        auto ld4 = [&](const TI& t, int i) __attribute__((always_inline)) -> f32x4 { return (f32x4){ld1(t, 4 * i), ld1(t, 4 * i + 1), ld1(t, 4 * i + 2), ld1(t, 4 * i + 3)}; };
        auto issue = [&](const TI& t, V8& v) __attribute__((always_inline)) { v.a = ld4(t, 0); v.b = ld4(t, 1); v.c = ld4(t, 2); v.d = ld4(t, 3); v.e = ld4(t, 4); v.f = ld4(t, 5); v.g = ld4(t, 6); v.h = ld4(t, 7); };
        auto st4 = [&](f32x4 x, int i) __attribute__((always_inline)) {
#pragma unroll
            for (int e = 0; e < 4; ++e) scr[(2 * (4 * i + e) + (lane >> 5)) * 33 + (lane & 31)] = x[e]; };
        auto proc = [&](const TI& t, const V8& v) __attribute__((always_inline)) {
            st4(v.a, 0); st4(v.b, 1); st4(v.c, 2); st4(v.d, 3); st4(v.e, 4); st4(v.f, 5); st4(v.g, 6); st4(v.h, 7);
            LDS_WAIT(); const int c = lane & 7;
#pragma unroll
            for (int j = 0; j < 4; ++j) { const int n = (lane >> 3) + 8 * j; const LAS float* sp = scr + (8 * c) * 33 + n;
                u32x4 o; o.x = cvt_pk_bf16(sp[0 * 33], sp[1 * 33]); o.y = cvt_pk_bf16(sp[2 * 33], sp[3 * 33]); o.z = cvt_pk_bf16(sp[4 * 33], sp[5 * 33]); o.w = cvt_pk_bf16(sp[6 * 33], sp[7 * 33]);
                *(u32x4*)(t.WT + (size_t)(t.n0 + n) * D + t.k0 + 8 * c) = o; }
            LDS_WAIT();
        };
        decode(gw, ta); issue(ta, va);
        for (int it = gw; it < NI; it += 2 * NGW) {
            { const int n1 = it + NGW < NI ? it + NGW : it; decode(n1, tb); issue(tb, vb); }
            proc(ta, va);
            { const int n2 = it + 2 * NGW < NI ? it + 2 * NGW : it; decode(n2, ta); issue(ta, va); }
            if (it + NGW < NI) proc(tb, vb);
        }
    }
    bf16_t* H = (bf16_t*)(p.ws + WS_H);
    for (int row = gw; row < NT; row += NGW) {
        const float* xr = row < NTP ? p.x_prompt + (size_t)row * D : p.x_sample + (size_t)(row - NTP) * D;
        f32x4 v[8]; float ss = 0.f;
#pragma unroll
        for (int j = 0; j < 8; ++j) { v[j] = __builtin_nontemporal_load((const f32x4*)(xr + j * 256 + lane * 4)); ss += (v[j][0] * v[j][0] + v[j][1] * v[j][1]) + (v[j][2] * v[j][2] + v[j][3] * v[j][3]); }
        const float inv = rsqrtf(wave_sum_fast(ss) * (1.0f / D) + EPS);
#pragma unroll
        for (int j = 0; j < 8; ++j) { const f32x4 g = *(const f32x4*)(p.ln_in_g + j * 256 + lane * 4);
            u32x2 o; o.x = cvt_pk_bf16(v[j][0] * inv * g[0], v[j][1] * inv * g[1]); o.y = cvt_pk_bf16(v[j][2] * inv * g[2], v[j][3] * inv * g[3]);
            *(u32x2*)(H + (size_t)row * D + j * 256 + lane * 4) = o; }
    }
}

__device__ __forceinline__ u32 bf16_1(float x) { return cvt_pk_bf16(x, 0.f) & 0xffffu; }
__device__ __forceinline__ void gla_prep_item(const Params& p, LAS unsigned char* lds, int bh, int c) {
    const int tid = otid(), dk = tid & 255, half = tid >> 8, w = tid >> 6, lane = tid & 63, fr = lane & 15, fq = lane >> 4;
    const int b = bh >> 2, h = bh & 3, row0 = b * SEQ + c * 64, item = bh * 32 + c;
    LAS bf16_t* qd_s = (LAS bf16_t*)lds; LAS bf16_t* kd_s = qd_s + 64 * 264; LAS float* lr_s = (LAS float*)(kd_s + 64 * 264); LAS float* hs_s = lr_s + 1024;
    const bf16_t* P = (const bf16_t*)(p.ws + WS_P);
    bf16_t* QD = (bf16_t*)(p.ws + WS_QD) + (size_t)item * 16384; bf16_t* KET = (bf16_t*)(p.ws + WS_KET) + (size_t)item * 16384;
    bf16_t* ATT = (bf16_t*)(p.ws + WS_ATT) + (size_t)item * 4096; float* Eg = (float*)(p.ws + WS_E) + (size_t)item * 256;
    for (int e = tid; e < 1024; e += 512) lr_s[e] = bf1(P[(size_t)(row0 + (e >> 4)) * N1 + C_LR + (e & 15)]);
    u32x4 rq[4], rk[4];
#pragma unroll
    for (int i = 0; i < 4; ++i) { const int e = tid + 512 * i; rq[i] = *(const u32x4*)(P + (size_t)(row0 + (e >> 5)) * N1 + C_QA + h * 256 + (e & 31) * 8); rk[i] = *(const u32x4*)(P + (size_t)(row0 + (e >> 5)) * N1 + C_KA + h * 256 + (e & 31) * 8); }
    float w2r[16];
#pragma unroll
    for (int r = 0; r < 16; ++r) w2r[r] = p.w_alpha2[r * 1024 + h * 256 + dk];
    const float bias = p.b_alpha[h * 256 + dk];
    __syncthreads();
    float la[32]; float hsum = 0.f;
#pragma unroll
    for (int i = 0; i < 32; ++i) { const int t = half * 32 + i; float x = 0.f;
#pragma unroll
        for (int r4 = 0; r4 < 4; ++r4) { const f32x4 l4 = *(const LAS f32x4*)(lr_s + t * 16 + r4 * 4); x += l4[0] * w2r[r4 * 4] + l4[1] * w2r[r4 * 4 + 1] + l4[2] * w2r[r4 * 4 + 2] + l4[3] * w2r[r4 * 4 + 3]; }
        x += bias;
        la[i] = (fminf(x, 0.f) - __logf(1.0f + __expf(-fabsf(x)))) * (1.0f / 16.0f); hsum += la[i]; }
    hs_s[half * 256 + dk] = hsum;
#pragma unroll
    for (int i = 0; i < 4; ++i) { const int e = tid + 512 * i; *(LAS u32x4*)(qd_s + (e >> 5) * 264 + (e & 31) * 8) = rq[i]; *(LAS u32x4*)(kd_s + (e >> 5) * 264 + (e & 31) * 8) = rk[i]; }
    __syncthreads();
    const float h0 = hs_s[dk], h1 = hs_s[256 + dk], blast = h0 + h1;
    float bcur = half ? h0 : 0.f;
    if (half == 0) Eg[dk] = __expf(blast);
    u32 kep[16];
#pragma unroll
    for (int i = 0; i < 32; ++i) { const int t = half * 32 + i; bcur += la[i];
        const float q = bf1(qd_s[t * 264 + dk]), k = bf1(kd_s[t * 264 + dk]);
        const u32 qd = bf16_1(q * __expf(bcur)), kd = bf16_1(k * __expf(-bcur));
        const float ke = k * __expf(blast - bcur);
        qd_s[t * 264 + dk] = (bf16_t)qd; kd_s[t * 264 + dk] = (bf16_t)kd;
        if (i & 1) kep[i >> 1] |= bf16_1(ke) << 16; else kep[i >> 1] = bf16_1(ke); }
#pragma unroll
    for (int i = 0; i < 4; ++i) *(u32x4*)(KET + dk * 64 + half * 32 + i * 8) = (u32x4){kep[4 * i], kep[4 * i + 1], kep[4 * i + 2], kep[4 * i + 3]};
    __syncthreads();
#pragma unroll
    for (int i = 0; i < 4; ++i) { const int e = tid + 512 * i; *(u32x4*)(QD + (e >> 5) * 256 + (e & 31) * 8) = *(const LAS u32x4*)(qd_s + (e >> 5) * 264 + (e & 31) * 8); }
    { const int ib = w >> 1;
      f32x4 acc[2]; acc[0] = (f32x4){0.f, 0.f, 0.f, 0.f}; acc[1] = acc[0];
#pragma unroll
      for (int kk = 0; kk < 8; ++kk) {
          const bf16x8 bq = *(const LAS bf16x8*)(qd_s + (16 * ib + fr) * 264 + kk * 32 + 8 * fq);
#pragma unroll
          for (int n = 0; n < 2; ++n) { const int jb = 2 * (w & 1) + n;
              const bf16x8 ak = *(const LAS bf16x8*)(kd_s + (16 * jb + fr) * 264 + kk * 32 + 8 * fq);
              acc[n] = __builtin_amdgcn_mfma_f32_16x16x32_bf16(ak, bq, acc[n], 0, 0, 0); } }
#pragma unroll
      for (int n = 0; n < 2; ++n) { const int jb = 2 * (w & 1) + n, i = 16 * ib + fr, j0 = 16 * jb + 4 * fq;
          float v0 = (j0 + 0 <= i) ? acc[n][0] : 0.f, v1 = (j0 + 1 <= i) ? acc[n][1] : 0.f, v2 = (j0 + 2 <= i) ? acc[n][2] : 0.f, v3 = (j0 + 3 <= i) ? acc[n][3] : 0.f;
          *(u32x2*)(ATT + i * 64 + j0) = (u32x2){cvt_pk_bf16(v0, v1), cvt_pk_bf16(v2, v3)}; } }
    __syncthreads();
}

__device__ __forceinline__ void phase2(const Params& p, LAS unsigned char* lds) {
    const int tid_ = otid(), lane = tid_ & 63, wave = tid_ >> 6;
    const int gw = blockIdx.x * 8 + wave, NGW = gridDim.x * 8;
    const bf16_t* P = (const bf16_t*)(p.ws + WS_P);
    float* QB = (float*)(p.ws + WS_QB); float* KB = (float*)(p.ws + WS_KB); float* VB = (float*)(p.ws + WS_VB);
    for (int it = gw; it < (NT / 8) * 12; it += NGW) {
        const int R = it / 12, quad = it % 12, tok0 = R * 8;
        int t0, sb; if (tok0 < NTP) { t0 = tok0 & (SEQ - 1); sb = -1; } else { t0 = 0; sb = (tok0 - NTP) >> 3; }
        f32x2 x[11][4], cw[4][4];
#pragma unroll
        for (int u = 0; u < 4; ++u) { const int c = (quad * 4 + u) * 128 + lane * 2;
#pragma unroll
            for (int i = 0; i < 4; ++i) cw[i][u] = *(const f32x2*)(p.conv_w + (size_t)i * 6144 + c);
#pragma unroll
            for (int j = 0; j < 11; ++j) {
                const int t = t0 - 3 + j;
                if (j >= 3 || t >= 0) { const u32 w = *(const u32*)(P + (size_t)(tok0 - 3 + j) * N1 + C_QKVB + c); x[j][u] = (f32x2){bf_lo(w), bf_hi(w)}; }
                else if (sb >= 0) x[j][u] = *(const f32x2*)(p.state_conv + ((size_t)sb * 3 + j) * 6144 + c);
                else x[j][u] = (f32x2){0.f, 0.f};
            } }
#pragma unroll
        for (int tt = 0; tt < 8; ++tt) {
            f32x2 y[4];
#pragma unroll
            for (int u = 0; u < 4; ++u) { f32x2 a = x[tt][u] * cw[0][u]; a += x[tt + 1][u] * cw[1][u]; a += x[tt + 2][u] * cw[2][u]; a += x[tt + 3][u] * cw[3][u];
                y[u] = (f32x2){siluf_(a[0]), siluf_(a[1])}; }
            const size_t tok = (size_t)(tok0 + tt);
            if (quad < 8) {
#pragma unroll
                for (int u = 0; u < 4; ++u) {
                    float sc = rsqrtf(wave_sum_fast(y[u][0] * y[u][0] + y[u][1] * y[u][1]) + EPS); if (quad < 4) sc *= 0.08838834764831845f;
                    float* dst = (quad < 4 ? QB : KB) + tok * D + ((quad & 3) * 4 + u) * 128 + lane * 2;
                    *(f32x2*)dst = y[u] * sc; }
            } else {
#pragma unroll
                for (int u = 0; u < 4; ++u) *(f32x2*)(VB + tok * D + ((quad - 8) * 4 + u) * 128 + lane * 2) = y[u];
            }
        }
    }
    float* ALPHA = (float*)(p.ws + WS_ALPHA);
    for (int it = gw; it < NTS * 4; it += NGW) {
        const int tok = NTP + (it >> 2), j = (it & 3) * 256 + lane * 4;
        f32x4 acc = (f32x4){0.f, 0.f, 0.f, 0.f};
#pragma unroll
        for (int r = 0; r < 16; ++r) { const float lr = bf1(P[(size_t)tok * N1 + C_LR + r]); acc += lr * *(const f32x4*)(p.w_alpha2 + r * 1024 + j); }
        acc += *(const f32x4*)(p.b_alpha + j);
        f32x4 o;
#pragma unroll
        for (int e = 0; e < 4; ++e) { const float x = acc[e]; const float ls = fminf(x, 0.f) - log1pf(expf(-fabsf(x))); o[e] = expf(ls * (1.0f / 16.0f)); }
        *(f32x4*)(ALPHA + (size_t)tok * 1024 + j) = o;
    }
    float* BETA = (float*)(p.ws + WS_BETA); float* GA = (float*)(p.ws + WS_GA);
    for (int it = gw; it < NT / 4; it += NGW) {
        const int tok = it * 4 + (lane >> 4), h = lane & 15;
        const float bb = bf1(P[(size_t)tok * N1 + C_BETA + h]), dd = bf1(P[(size_t)tok * N1 + C_DEC + h]);
        BETA[tok * 16 + h] = 1.0f / (1.0f + expf(-bb));
        const float g = -expf(p.a_log[h]) * softplusf_(dd + p.dt_bias[h]);
        GA[tok * 16 + h] = expf(g); ((float*)(p.ws + WS_GL))[tok * 16 + h] = g;
    }
    const int gt = blockIdx.x * 512 + tid_, NG = gridDim.x * 512;
    for (int i = gt; i < (4 + 128) * 3 * 768; i += NG) {
        const int seq = i / (3 * 768), r = (i / 768) % 3, c8 = (i % 768) * 8;
        const size_t row = seq < 4 ? (size_t)(seq * SEQ + SEQ - 3 + r) : (size_t)(NTP + (seq - 4) * DSEQ + DSEQ - 3 + r);
        float* dst = seq < 4 ? p.out + O_CONV_P + ((size_t)seq * 3 + r) * 6144 + c8 : p.out + O_CONV_S + ((size_t)(seq - 4) * 3 + r) * 6144 + c8;
        const u32x4 w = *(const u32x4*)(P + row * N1 + C_QKVB + c8);
        *(f32x4*)dst = (f32x4){bf_lo(w.x), bf_hi(w.x), bf_lo(w.y), bf_hi(w.y)}; *(f32x4*)(dst + 4) = (f32x4){bf_lo(w.z), bf_hi(w.z), bf_lo(w.w), bf_hi(w.w)};
    }
    for (int it = blockIdx.x; it < 512; it += gridDim.x) gla_prep_item(p, lds, it >> 5, it & 31);
}

__device__ __forceinline__ void gla_sample_item(const Params& p, LAS unsigned char* lds, int b, int h) {
    const int tid = otid(), w = tid >> 6, lane = tid & 63, dkl = lane >> 3, dvl = lane & 7, dkb = w * 32 + dkl * 4;
    LAS float* qs = (LAS float*)lds; LAS float* ks = qs + 2048; LAS float* as = ks + 2048; LAS float* vs = as + 2048; LAS float* part = vs + 4096;
    const bf16_t* P = (const bf16_t*)(p.ws + WS_P); const float* ALPHA = (const float*)(p.ws + WS_ALPHA); float* OA = (float*)(p.ws + WS_OA);
    const int row0 = NTP + b * DSEQ;
    const float* st_in = p.state_gla + (size_t)(b * 4 + h) * 131072; float* st_out = p.out + O_GLA_S + (size_t)(b * 4 + h) * 131072;
    f32x4 Sn[4];
#pragma unroll
    for (int i = 0; i < 4; ++i) Sn[i] = __builtin_nontemporal_load((const f32x4*)(st_in + (size_t)(dkb + i) * 512 + dvl * 4));
    { const int tt = tid >> 6, pc = tid & 63; const size_t row = (size_t)(row0 + tt);
      const u32x2 rq = *(const u32x2*)(P + row * N1 + C_QA + h * 256 + pc * 4), rk = *(const u32x2*)(P + row * N1 + C_KA + h * 256 + pc * 4);
      const f32x4 ra = *(const f32x4*)(ALPHA + row * 1024 + h * 256 + pc * 4);
      const u32x4 rv = *(const u32x4*)(P + row * N1 + C_VA + h * 512 + pc * 8);
      *(LAS f32x4*)(qs + tt * 256 + pc * 4) = (f32x4){bf_lo(rq.x), bf_hi(rq.x), bf_lo(rq.y), bf_hi(rq.y)};
      *(LAS f32x4*)(ks + tt * 256 + pc * 4) = (f32x4){bf_lo(rk.x), bf_hi(rk.x), bf_lo(rk.y), bf_hi(rk.y)};
      *(LAS f32x4*)(as + tt * 256 + pc * 4) = ra;
      *(LAS f32x4*)(vs + tt * 512 + pc * 8) = (f32x4){bf_lo(rv.x), bf_hi(rv.x), bf_lo(rv.y), bf_hi(rv.y)};
      *(LAS f32x4*)(vs + tt * 512 + pc * 8 + 4) = (f32x4){bf_lo(rv.z), bf_hi(rv.z), bf_lo(rv.w), bf_hi(rv.w)}; }
    __syncthreads();
    for (int s = 0; s < 16; ++s) {
        f32x4 S[4];
#pragma unroll
        for (int i = 0; i < 4; ++i) S[i] = Sn[i];
        { const int sn = (s + 1) & 15;
#pragma unroll
            for (int i = 0; i < 4; ++i) Sn[i] = __builtin_nontemporal_load((const f32x4*)(st_in + (size_t)(dkb + i) * 512 + sn * 32 + dvl * 4));
        }
        LAS float* pt = part + (s & 1) * 2048;
#pragma unroll 2
        for (int t = 0; t < 8; ++t) {
            const f32x4 q4 = *(const LAS f32x4*)(qs + t * 256 + dkb), k4 = *(const LAS f32x4*)(ks + t * 256 + dkb), a4 = *(const LAS f32x4*)(as + t * 256 + dkb);
            const f32x4 v4 = *(const LAS f32x4*)(vs + t * 512 + s * 32 + dvl * 4);
            f32x4 o = (f32x4){0.f, 0.f, 0.f, 0.f};
#pragma unroll
            for (int i = 0; i < 4; ++i) { S[i] = a4[i] * S[i] + k4[i] * v4; o += q4[i] * S[i]; }
#pragma unroll
            for (int j = 0; j < 4; ++j) (void)j;
            {
                const auto r01 = __builtin_amdgcn_permlane32_swap(__float_as_uint(o[0]), __float_as_uint(o[1]), false, false);
                const auto r23 = __builtin_amdgcn_permlane32_swap(__float_as_uint(o[2]), __float_as_uint(o[3]), false, false);
                const float s01 = __uint_as_float(r01[0]) + __uint_as_float(r01[1]), s23 = __uint_as_float(r23[0]) + __uint_as_float(r23[1]);
                const auto rr = __builtin_amdgcn_permlane16_swap(__float_as_uint(s01), __float_as_uint(s23), false, false);
                float x = __uint_as_float(rr[0]) + __uint_as_float(rr[1]);
                x += dpp<ROR8>(x);
                const int R = lane >> 4;
                if ((lane & 8) == 0) pt[(w * 8 + t) * 32 + dvl * 4 + (((R & 1) << 1) | (R >> 1))] = x; }
        }
#pragma unroll
        for (int i = 0; i < 4; ++i) __builtin_nontemporal_store(S[i], (f32x4*)(st_out + (size_t)(dkb + i) * 512 + s * 32 + dvl * 4));
        lds_barrier();
        if (tid < 256) { const int tt = tid >> 5, pc = tid & 31; float sum = 0.f;
#pragma unroll
            for (int ww = 0; ww < 8; ++ww) sum += pt[(ww * 8 + tt) * 32 + pc];
            OA[(size_t)(row0 + tt) * D + h * 512 + s * 32 + pc] = sum * 0.0625f; }
    }
    __syncthreads();
}
__device__ __forceinline__ void gdn_item(const Params& p, LAS unsigned char* lds, int row0, int T, int h, int s, const float* st_in, float* st_out) {
    const int tid = otid(), w = tid >> 6, lane = tid & 63, g = lane >> 2, j = lane & 3, dvl = w * 4 + j;
    LAS float* qs = (LAS float*)lds; LAS float* ks = qs + 2048; LAS float* vs = ks + 2048; LAS float* bs = vs + 512; LAS float* gs = bs + 16; LAS float* os = gs + 16; LAS float* sst = os + 512;
    const float* QB = (const float*)(p.ws + WS_QB); const float* KB = (const float*)(p.ws + WS_KB); const float* VB = (const float*)(p.ws + WS_VB);
    const float* BETA = (const float*)(p.ws + WS_BETA); const float* GA = (const float*)(p.ws + WS_GA); float* OB = (float*)(p.ws + WS_OB);
    float S[8];
    if (st_in) {
#pragma unroll
        for (int i = 0; i < 8; ++i) { const int e = tid + 512 * i; sst[(e >> 5) * 33 + (e & 31)] = st_in[(size_t)(e >> 5) * 128 + s * 32 + (e & 31)]; }
        __syncthreads();
#pragma unroll
        for (int i = 0; i < 8; ++i) S[i] = sst[(g * 8 + i) * 33 + dvl];
    } else {
#pragma unroll
        for (int i = 0; i < 8; ++i) S[i] = 0.f;
    }
    const int tt = tid >> 5, pc = tid & 31;
    f32x4 rq, rk; float rv, rb, ra;
    auto load_regs = [&](int t0) {
        const int t = t0 + tt;
        if (t < T) { const size_t row = (size_t)(row0 + t);
            rq = *(const f32x4*)(QB + row * D + h * 128 + pc * 4); rk = *(const f32x4*)(KB + row * D + h * 128 + pc * 4);
            rv = VB[row * D + h * 128 + s * 32 + pc];
            if (pc == 0) { rb = BETA[row * 16 + h]; ra = GA[row * 16 + h]; } }
        else { rq = (f32x4){0.f, 0.f, 0.f, 0.f}; rk = rq; rv = 0.f; rb = 0.f; ra = 1.f; }
    };
    load_regs(0);
    for (int t0 = 0; t0 < T; t0 += 16) {
        const int nt = (T - t0) < 16 ? (T - t0) : 16;
        *(LAS f32x4*)(qs + tt * 128 + pc * 4) = rq; *(LAS f32x4*)(ks + tt * 128 + pc * 4) = rk; vs[tt * 32 + pc] = rv;
        if (pc == 0) { bs[tt] = rb; gs[tt] = ra; }
        __syncthreads();
        if (t0 + 16 < T) load_regs(t0 + 16);
        for (int t = 0; t < nt; ++t) {
            const f32x4 k0 = *(const LAS f32x4*)(ks + t * 128 + g * 8), k1 = *(const LAS f32x4*)(ks + t * 128 + g * 8 + 4);
            const f32x4 q0 = *(const LAS f32x4*)(qs + t * 128 + g * 8), q1 = *(const LAS f32x4*)(qs + t * 128 + g * 8 + 4);
            const float v = vs[t * 32 + dvl], a = gs[t], b = bs[t];
            float kS = 0.f, qS = 0.f, qk = 0.f;
#pragma unroll
            for (int i = 0; i < 4; ++i) { kS += k0[i] * S[i]; qS += q0[i] * S[i]; qk += q0[i] * k0[i]; }
#pragma unroll
            for (int i = 0; i < 4; ++i) { kS += k1[i] * S[4 + i]; qS += q1[i] * S[4 + i]; qk += q1[i] * k1[i]; }
            kS += dpp<ROR4>(kS); qS += dpp<ROR4>(qS); qk += dpp<ROR4>(qk);
            kS += dpp<ROR8>(kS); qS += dpp<ROR8>(qS); qk += dpp<ROR8>(qk);
            kS = xrow16_sum(kS); qS = xrow16_sum(qS); qk = xrow16_sum(qk);
            const float u = v - a * kS, bu = b * u;
            const float o = a * qS + qk * bu;
#pragma unroll
            for (int i = 0; i < 4; ++i) { S[i] = a * S[i] + bu * k0[i]; S[4 + i] = a * S[4 + i] + bu * k1[i]; }
            if (lane < 4) os[t * 32 + dvl] = o;
        }
        __syncthreads();
        if (tt < nt) OB[(size_t)(row0 + t0 + tt) * D + h * 128 + s * 32 + pc] = os[tt * 32 + pc];
    }
#pragma unroll
    for (int i = 0; i < 8; ++i) sst[(g * 8 + i) * 33 + dvl] = S[i];
    __syncthreads();
#pragma unroll
    for (int i = 0; i < 8; ++i) { const int e = tid + 512 * i; st_out[(size_t)(e >> 5) * 128 + s * 32 + (e & 31)] = sst[(e >> 5) * 33 + (e & 31)]; }
    __syncthreads();
}
__device__ __forceinline__ void gdn_sample_item(const Params& p, LAS unsigned char* lds, int b, int h) {
    const int tid = otid(), w = tid >> 6, lane = tid & 63, g = lane >> 2, j = lane & 3, dvl = w * 4 + j;
    LAS float* qs = (LAS float*)lds; LAS float* ks = qs + 1024; LAS float* vs = ks + 1024; LAS float* bts = vs + 1024; LAS float* egs = bts + 8; LAS float* els = egs + 8; LAS float* ghs = els + 8;
    LAS float* Mm = ghs + 16; LAS float* QKm = Mm + 64; LAS float* os = QKm + 64; LAS float* red = os + 512; LAS float* sst = red + 512;
    const float* QB = (const float*)(p.ws + WS_QB); const float* KB = (const float*)(p.ws + WS_KB); const float* VB = (const float*)(p.ws + WS_VB);
    const float* BETA = (const float*)(p.ws + WS_BETA); const float* GL = (const float*)(p.ws + WS_GL); float* OB = (float*)(p.ws + WS_OB);
    const int row0 = NTP + b * DSEQ;
    const float* st_in = p.state_gdn + (size_t)(b * 16 + h) * 16384; float* st_out = p.out + O_GDN_S + (size_t)(b * 16 + h) * 16384;
    float pre[8];
#pragma unroll
    for (int i = 0; i < 8; ++i) { const int e = tid + 512 * i; pre[i] = __builtin_nontemporal_load(st_in + (size_t)(e >> 5) * 128 + (e & 31)); }
    if (tid < 256) { const int tt = tid >> 5, pc = tid & 31; const size_t row = (size_t)(row0 + tt);
        *(LAS f32x4*)(qs + tt * 128 + pc * 4) = *(const f32x4*)(QB + row * D + h * 128 + pc * 4);
        *(LAS f32x4*)(ks + tt * 128 + pc * 4) = *(const f32x4*)(KB + row * D + h * 128 + pc * 4);
        *(LAS f32x4*)(vs + tt * 128 + pc * 4) = *(const f32x4*)(VB + row * D + h * 128 + pc * 4); }
    if (w == 4) {
        const int t = lane & 7; float gv = GL[(size_t)(row0 + t) * 16 + h];
#pragma unroll
        for (int o = 1; o < 8; o <<= 1) { const float y = __shfl_up(gv, o); if (t >= o) gv += y; }
        const float gh7 = __shfl(gv, 7);
        if (lane < 8) { ghs[t] = gv; egs[t] = expf(gv); bts[t] = BETA[(size_t)(row0 + t) * 16 + h]; els[t] = expf(gh7 - gv); if (t == 7) ghs[8] = expf(gv); } }
#pragma unroll
    for (int i = 0; i < 8; ++i) { const int e = tid + 512 * i; sst[(e >> 5) * 33 + (e & 31)] = pre[i]; }
    __syncthreads();
    {
        const int t = tid >> 6, jj = (tid >> 3) & 7, part = tid & 7; float kk = 0.f, qk = 0.f;
#pragma unroll
        for (int i = 0; i < 4; ++i) { const f32x4 kt = *(const LAS f32x4*)(ks + t * 128 + part * 16 + 4 * i), kj = *(const LAS f32x4*)(ks + jj * 128 + part * 16 + 4 * i), qt = *(const LAS f32x4*)(qs + t * 128 + part * 16 + 4 * i);
            kk += kt[0] * kj[0] + kt[1] * kj[1] + kt[2] * kj[2] + kt[3] * kj[3]; qk += qt[0] * kj[0] + qt[1] * kj[1] + qt[2] * kj[2] + qt[3] * kj[3]; }
        kk += dpp<0xB1>(kk); qk += dpp<0xB1>(qk); kk += dpp<0x4E>(kk); qk += dpp<0x4E>(qk); kk += dpp<0x141>(kk); qk += dpp<0x141>(qk);
        if (part == 0) { const float dec = expf(ghs[t] - ghs[jj]); Mm[t * 8 + jj] = jj < t ? bts[t] * kk * dec : 0.f; QKm[t * 8 + jj] = jj <= t ? qk * dec : 0.f; }
    }
    __syncthreads();
    const int b5 = lane >> 5, b4 = (lane >> 4) & 1, b3 = (lane >> 3) & 1, b2 = (lane >> 2) & 1;
    const int ridx = 8 * b2 + 4 * b3 + 2 * b4 + b5;
    LAS float* myred = red + (w * 4 + j) * 16;
    for (int s = 0; s < 4; ++s) {
        LAS float* cur = sst + (s & 1) * 4224; LAS float* nxt = sst + ((s + 1) & 1) * 4224;
        float S[8];
#pragma unroll
        for (int i = 0; i < 8; ++i) S[i] = cur[(g * 8 + i) * 33 + dvl];
        { const int sn = (s + 1) & 3;
#pragma unroll
            for (int i = 0; i < 8; ++i) { const int e = tid + 512 * i; pre[i] = __builtin_nontemporal_load(st_in + (size_t)(e >> 5) * 128 + sn * 32 + (e & 31)); }
        }
        f32x4 kr0[8], kr1[8]; float v16[16];
#pragma unroll
        for (int t = 0; t < 8; ++t) {
            kr0[t] = *(const LAS f32x4*)(ks + t * 128 + g * 8); kr1[t] = *(const LAS f32x4*)(ks + t * 128 + g * 8 + 4);
            const f32x4 q0 = *(const LAS f32x4*)(qs + t * 128 + g * 8), q1 = *(const LAS f32x4*)(qs + t * 128 + g * 8 + 4);
            float a = 0.f, c = 0.f;
#pragma unroll
            for (int i = 0; i < 4; ++i) { a += kr0[t][i] * S[i]; c += q0[i] * S[i]; }
#pragma unroll
            for (int i = 0; i < 4; ++i) { a += kr1[t][i] * S[4 + i]; c += q1[i] * S[4 + i]; }
            v16[t] = a; v16[8 + t] = c; }
        float wA[8], xB[4], yC[2];
#pragma unroll
        for (int m = 0; m < 8; ++m) { const auto r = __builtin_amdgcn_permlane32_swap(__float_as_uint(v16[2 * m]), __float_as_uint(v16[2 * m + 1]), false, false); wA[m] = __uint_as_float(r[0]) + __uint_as_float(r[1]); }
#pragma unroll
        for (int n = 0; n < 4; ++n) { const auto r = __builtin_amdgcn_permlane16_swap(__float_as_uint(wA[2 * n]), __float_as_uint(wA[2 * n + 1]), false, false); xB[n] = __uint_as_float(r[0]) + __uint_as_float(r[1]); }
#pragma unroll
        for (int q = 0; q < 2; ++q) { const float send = b3 ? xB[2 * q] : xB[2 * q + 1], keep = b3 ? xB[2 * q + 1] : xB[2 * q]; yC[q] = keep + dpp<ROR8>(send); }
        float zD; { const float send = b2 ? yC[0] : yC[1], keep = b2 ? yC[1] : yC[0]; zD = keep + __shfl_xor(send, 4); }
        myred[ridx] = zD;
        LDS_WAIT();
        float r16[16];
#pragma unroll
        for (int i = 0; i < 4; ++i) { const f32x4 x = *(const LAS f32x4*)(myred + 4 * i); r16[4 * i] = x[0]; r16[4 * i + 1] = x[1]; r16[4 * i + 2] = x[2]; r16[4 * i + 3] = x[3]; }
        LDS_WAIT();
        LAS float* ot = os + (s & 1) * 256;
        float vn[8];
#pragma unroll
        for (int t = 0; t < 8; ++t) {
            float x = bts[t] * (vs[t * 128 + s * 32 + dvl] - egs[t] * r16[t]);
            float o = egs[t] * r16[8 + t];
#pragma unroll
            for (int jj = 0; jj < 8; ++jj) { if (jj < t) { x -= Mm[t * 8 + jj] * vn[jj]; o += QKm[t * 8 + jj] * vn[jj]; } }
            vn[t] = x; o += QKm[t * 8 + t] * x;
            if (lane < 4) ot[t * 32 + dvl] = o; }
        { const float e7 = ghs[8];
#pragma unroll
          for (int i = 0; i < 8; ++i) S[i] *= e7;
#pragma unroll
          for (int t = 0; t < 8; ++t) { const float c = els[t] * vn[t];
#pragma unroll
              for (int i = 0; i < 4; ++i) { S[i] += kr0[t][i] * c; S[4 + i] += kr1[t][i] * c; } } }
#pragma unroll
        for (int i = 0; i < 8; ++i) cur[(g * 8 + i) * 33 + dvl] = S[i];
        if (s + 1 < 4) {
#pragma unroll
            for (int i = 0; i < 8; ++i) { const int e = tid + 512 * i; nxt[(e >> 5) * 33 + (e & 31)] = pre[i]; }
        }
        lds_barrier();
#pragma unroll
        for (int i = 0; i < 8; ++i) { const int e = tid + 512 * i; __builtin_nontemporal_store(cur[(e >> 5) * 33 + (e & 31)], st_out + (size_t)(e >> 5) * 128 + s * 32 + (e & 31)); }
        if (tid < 256) OB[(size_t)(row0 + (tid >> 5)) * D + h * 128 + s * 32 + (tid & 31)] = ot[tid];
        lds_barrier();
    }
}
__device__ __forceinline__ void gdn_prep_item(const Params& p, LAS unsigned char* lds, int bh, int cg) {
    const int tid = otid(), w = tid >> 6, lane = tid & 63, fr = lane & 15, fq = lane >> 4;
    const int b = bh >> 4, h = bh & 15;
    LAS bf16_t* k_s = (LAS bf16_t*)lds; LAS bf16_t* q_s = k_s + 64 * 136; LAS bf16_t* klo_s = q_s + 64 * 136;
    LAS float* mp = (LAS float*)(lds + 53248);
    LAS float* gh_all = (LAS float*)(lds + 120832); LAS float* bt_all = gh_all + 512;
    const bf16_t* P = (const bf16_t*)(p.ws + WS_P);
    const float* QB = (const float*)(p.ws + WS_QB); const float* KB = (const float*)(p.ws + WS_KB); const float* VB = (const float*)(p.ws + WS_VB);
    const int item0 = bh * 32 + cg * 8, rowg = b * SEQ + cg * 512;
    { const size_t row = (size_t)(rowg + w * 64 + lane);
      const float bt = 1.0f / (1.0f + expf(-bf1(P[row * N1 + C_BETA + h])));
      float g = -expf(p.a_log[h]) * softplusf_(bf1(P[row * N1 + C_DEC + h]) + p.dt_bias[h]);
#pragma unroll
      for (int o = 1; o < 64; o <<= 1) { const float y = __shfl_up(g, o); if (lane >= o) g += y; }
      gh_all[w * 64 + lane] = g; bt_all[w * 64 + lane] = bt;
      if (lane == 63) ((float*)(p.ws + WS_GEG))[item0 + w] = expf(g); }
    const int t = tid >> 3, pc = tid & 7;
    f32x4 kvn[4], qvn[4];
#pragma unroll
    for (int i = 0; i < 4; ++i) { kvn[i] = *(const f32x4*)(KB + (size_t)(rowg + t) * D + h * 128 + pc * 16 + 4 * i); qvn[i] = *(const f32x4*)(QB + (size_t)(rowg + t) * D + h * 128 + pc * 16 + 4 * i); }
    __syncthreads();
    for (int cc = 0; cc < 8; ++cc) {
        const int item = item0 + cc;
        f32x4 qv[4];
        { u32 kh[8], kl[8], qh[8];
#pragma unroll
          for (int i = 0; i < 4; ++i) { const f32x4 kv = kvn[i]; qv[i] = qvn[i];
              kh[2 * i] = cvt_pk_bf16(kv[0], kv[1]); kh[2 * i + 1] = cvt_pk_bf16(kv[2], kv[3]);
              kl[2 * i] = cvt_pk_bf16(kv[0] - bf_lo(kh[2 * i]), kv[1] - bf_hi(kh[2 * i])); kl[2 * i + 1] = cvt_pk_bf16(kv[2] - bf_lo(kh[2 * i + 1]), kv[3] - bf_hi(kh[2 * i + 1]));
              qh[2 * i] = cvt_pk_bf16(qv[i][0], qv[i][1]); qh[2 * i + 1] = cvt_pk_bf16(qv[i][2], qv[i][3]); }
          *(LAS u32x4*)(k_s + t * 136 + pc * 16) = (u32x4){kh[0], kh[1], kh[2], kh[3]}; *(LAS u32x4*)(k_s + t * 136 + pc * 16 + 8) = (u32x4){kh[4], kh[5], kh[6], kh[7]};
          *(LAS u32x4*)(klo_s + t * 136 + pc * 16) = (u32x4){kl[0], kl[1], kl[2], kl[3]}; *(LAS u32x4*)(klo_s + t * 136 + pc * 16 + 8) = (u32x4){kl[4], kl[5], kl[6], kl[7]};
          *(LAS u32x4*)(q_s + t * 136 + pc * 16) = (u32x4){qh[0], qh[1], qh[2], qh[3]}; *(LAS u32x4*)(q_s + t * 136 + pc * 16 + 8) = (u32x4){qh[4], qh[5], qh[6], qh[7]}; }
        lds_barrier();
        { const int cn = cc + 1 < 8 ? cc + 1 : 7;
#pragma unroll
          for (int i = 0; i < 4; ++i) { kvn[i] = *(const f32x4*)(KB + (size_t)(rowg + cn * 64 + t) * D + h * 128 + pc * 16 + 4 * i); qvn[i] = *(const f32x4*)(QB + (size_t)(rowg + cn * 64 + t) * D + h * 128 + pc * 16 + 4 * i); } }
        const LAS float* gh = gh_all + cc * 64; const LAS float* bt = bt_all + cc * 64;
        {
          const float e = __expf(gh[t]); bf16_t* dst = (bf16_t*)(p.ws + WS_GQG) + (size_t)item * 8192 + t * 128 + pc * 16;
          *(u32x4*)dst = (u32x4){cvt_pk_bf16(qv[0][0] * e, qv[0][1] * e), cvt_pk_bf16(qv[0][2] * e, qv[0][3] * e), cvt_pk_bf16(qv[1][0] * e, qv[1][1] * e), cvt_pk_bf16(qv[1][2] * e, qv[1][3] * e)};
          *(u32x4*)(dst + 8) = (u32x4){cvt_pk_bf16(qv[2][0] * e, qv[2][1] * e), cvt_pk_bf16(qv[2][2] * e, qv[2][3] * e), cvt_pk_bf16(qv[3][0] * e, qv[3][1] * e), cvt_pk_bf16(qv[3][2] * e, qv[3][3] * e)}; }
        {
          const int dk = tid & 127, qt = tid >> 7; const float gl = gh[63]; u32 pk[8];
#pragma unroll
          for (int i = 0; i < 8; ++i) { const int t0 = qt * 16 + 2 * i;
              const float k0 = (bf1(k_s[t0 * 136 + dk]) + bf1(klo_s[t0 * 136 + dk])) * __expf(gl - gh[t0]), k1 = (bf1(k_s[(t0 + 1) * 136 + dk]) + bf1(klo_s[(t0 + 1) * 136 + dk])) * __expf(gl - gh[t0 + 1]);
              pk[i] = cvt_pk_bf16(k0, k1); }
          bf16_t* dst = (bf16_t*)(p.ws + WS_GKE) + (size_t)item * 8192 + dk * 64 + qt * 16;
          *(u32x4*)dst = (u32x4){pk[0], pk[1], pk[2], pk[3]}; *(u32x4*)(dst + 8) = (u32x4){pk[4], pk[5], pk[6], pk[7]}; }
        {
          const int ib = w >> 1;
          f32x4 am[2], aq[2]; am[0] = (f32x4){0.f, 0.f, 0.f, 0.f}; am[1] = am[0]; aq[0] = am[0]; aq[1] = am[0];
#pragma unroll
          for (int kk = 0; kk < 4; ++kk) {
              const bf16x8 ki = *(const LAS bf16x8*)(k_s + (16 * ib + fr) * 136 + kk * 32 + 8 * fq), qi = *(const LAS bf16x8*)(q_s + (16 * ib + fr) * 136 + kk * 32 + 8 * fq);
              const bf16x8 kil = *(const LAS bf16x8*)(klo_s + (16 * ib + fr) * 136 + kk * 32 + 8 * fq);
#pragma unroll
              for (int n = 0; n < 2; ++n) { const int jb = 2 * (w & 1) + n;
                  const bf16x8 kj = *(const LAS bf16x8*)(k_s + (16 * jb + fr) * 136 + kk * 32 + 8 * fq), kjl = *(const LAS bf16x8*)(klo_s + (16 * jb + fr) * 136 + kk * 32 + 8 * fq);
                  am[n] = __builtin_amdgcn_mfma_f32_16x16x32_bf16(ki, kj, am[n], 0, 0, 0);
                  am[n] = __builtin_amdgcn_mfma_f32_16x16x32_bf16(ki, kjl, am[n], 0, 0, 0);
                  am[n] = __builtin_amdgcn_mfma_f32_16x16x32_bf16(kil, kj, am[n], 0, 0, 0);
                  aq[n] = __builtin_amdgcn_mfma_f32_16x16x32_bf16(kj, qi, aq[n], 0, 0, 0); } }
          LAS float* mpc = mp + cc * 2048;
          bf16_t* QKM = (bf16_t*)(p.ws + WS_GQKM) + (size_t)item * 4096;
#pragma unroll
          for (int n = 0; n < 2; ++n) { const int jb = 2 * (w & 1) + n;
              { const int j = 16 * jb + fr; const float ghj = gh[j];
#pragma unroll
                for (int r = 0; r < 4; ++r) { const int i = 16 * ib + 4 * fq + r; if (j < i) mpc[i * (i - 1) / 2 + j] = bt[i] * am[n][r] * __expf(gh[i] - ghj); } }
              { const int i = 16 * ib + fr, j0 = 16 * jb + 4 * fq; const float ghi = gh[i]; float v[4];
#pragma unroll
                for (int r = 0; r < 4; ++r) v[r] = (j0 + r <= i) ? aq[n][r] * __expf(ghi - gh[j0 + r]) : 0.f;
                *(u32x2*)(QKM + i * 64 + j0) = (u32x2){cvt_pk_bf16(v[0], v[1]), cvt_pk_bf16(v[2], v[3])}; } } }
        lds_barrier();
    }
    { const LAS float* mw = mp + w * 2048; float Tr[64];
      float* TG = (float*)(p.ws + WS_GT) + (size_t)(item0 + w) * 4096;
#pragma unroll
      for (int i = 0; i < 64; ++i) { float acc = (lane == i) ? 1.f : 0.f;
#pragma unroll
          for (int j = 0; j < i; ++j) acc -= mw[i * (i - 1) / 2 + j] * Tr[j];
          Tr[i] = acc; TG[i * 64 + lane] = acc; } }
    __syncthreads();
    LAS bf16_t* T_s = (LAS bf16_t*)lds; LAS bf16_t* Tl_s = T_s + 64 * 72; LAS bf16_t* BVT_s = Tl_s + 64 * 72; LAS bf16_t* BVTl_s = BVT_s + 128 * 72; LAS bf16_t* KGT_s = BVTl_s + 128 * 72; LAS bf16_t* KGTl_s = KGT_s + 128 * 72;
    const int col = tid & 127, tq = tid >> 7;
    f32x4 tn0, tn1; float vcn[16], kcn[16];
    auto load3 = [&](int cc) __attribute__((always_inline)) {
        const float* tr = (const float*)(p.ws + WS_GT) + (size_t)(item0 + cc) * 4096 + t * 64 + pc * 8; tn0 = *(const f32x4*)tr; tn1 = *(const f32x4*)(tr + 4);
#pragma unroll
        for (int i = 0; i < 16; ++i) { const size_t row = (size_t)(rowg + cc * 64 + tq * 16 + i); vcn[i] = VB[row * D + h * 128 + col]; kcn[i] = KB[row * D + h * 128 + col]; }
    };
    load3(0);
    for (int cc = 0; cc < 8; ++cc) {
        const int item = item0 + cc;
        const LAS float* gh = gh_all + cc * 64; const LAS float* bt = bt_all + cc * 64;
        { const f32x4 t0 = tn0, t1 = tn1;
          const u32 h0 = cvt_pk_bf16(t0[0], t0[1]), h1 = cvt_pk_bf16(t0[2], t0[3]), h2 = cvt_pk_bf16(t1[0], t1[1]), h3 = cvt_pk_bf16(t1[2], t1[3]);
          *(LAS u32x4*)(T_s + t * 72 + pc * 8) = (u32x4){h0, h1, h2, h3};
          *(LAS u32x4*)(Tl_s + t * 72 + pc * 8) = (u32x4){cvt_pk_bf16(t0[0] - bf_lo(h0), t0[1] - bf_hi(h0)), cvt_pk_bf16(t0[2] - bf_lo(h1), t0[3] - bf_hi(h1)), cvt_pk_bf16(t1[0] - bf_lo(h2), t1[1] - bf_hi(h2)), cvt_pk_bf16(t1[2] - bf_lo(h3), t1[3] - bf_hi(h3))}; }
        { u32 vh[8], vl[8], kh[8], kl[8];
#pragma unroll
          for (int i = 0; i < 8; ++i) { const int ta = tq * 16 + 2 * i; const float b0 = bt[ta], b1 = bt[ta + 1];
              const float xv0 = vcn[2 * i] * b0, xv1 = vcn[2 * i + 1] * b1, xk0 = kcn[2 * i] * b0 * __expf(gh[ta]), xk1 = kcn[2 * i + 1] * b1 * __expf(gh[ta + 1]);
              vh[i] = cvt_pk_bf16(xv0, xv1); vl[i] = cvt_pk_bf16(xv0 - bf_lo(vh[i]), xv1 - bf_hi(vh[i])); kh[i] = cvt_pk_bf16(xk0, xk1); kl[i] = cvt_pk_bf16(xk0 - bf_lo(kh[i]), xk1 - bf_hi(kh[i])); }
          const int o = col * 72 + tq * 16;
          *(LAS u32x4*)(BVT_s + o) = (u32x4){vh[0], vh[1], vh[2], vh[3]}; *(LAS u32x4*)(BVT_s + o + 8) = (u32x4){vh[4], vh[5], vh[6], vh[7]};
          *(LAS u32x4*)(BVTl_s + o) = (u32x4){vl[0], vl[1], vl[2], vl[3]}; *(LAS u32x4*)(BVTl_s + o + 8) = (u32x4){vl[4], vl[5], vl[6], vl[7]};
          *(LAS u32x4*)(KGT_s + o) = (u32x4){kh[0], kh[1], kh[2], kh[3]}; *(LAS u32x4*)(KGT_s + o + 8) = (u32x4){kh[4], kh[5], kh[6], kh[7]};
          *(LAS u32x4*)(KGTl_s + o) = (u32x4){kl[0], kl[1], kl[2], kl[3]}; *(LAS u32x4*)(KGTl_s + o + 8) = (u32x4){kl[4], kl[5], kl[6], kl[7]}; }
        lds_barrier();
        load3(cc + 1 < 8 ? cc + 1 : 7);
        { f32x4 au[4], aw[4];
#pragma unroll
          for (int ib = 0; ib < 4; ++ib) { au[ib] = (f32x4){0.f, 0.f, 0.f, 0.f}; aw[ib] = au[ib]; }
#pragma unroll
          for (int kk = 0; kk < 2; ++kk) {
              const int ao = (16 * w + fr) * 72 + kk * 32 + 8 * fq;
              const bf16x8 av = *(const LAS bf16x8*)(BVT_s + ao), avl = *(const LAS bf16x8*)(BVTl_s + ao), ak = *(const LAS bf16x8*)(KGT_s + ao), akl = *(const LAS bf16x8*)(KGTl_s + ao);
#pragma unroll
              for (int ib = 0; ib < 4; ++ib) { const int bo = (16 * ib + fr) * 72 + kk * 32 + 8 * fq;
                  const bf16x8 tb = *(const LAS bf16x8*)(T_s + bo), tl = *(const LAS bf16x8*)(Tl_s + bo);
                  au[ib] = __builtin_amdgcn_mfma_f32_16x16x32_bf16(av, tb, au[ib], 0, 0, 0); au[ib] = __builtin_amdgcn_mfma_f32_16x16x32_bf16(avl, tb, au[ib], 0, 0, 0); au[ib] = __builtin_amdgcn_mfma_f32_16x16x32_bf16(av, tl, au[ib], 0, 0, 0);
                  aw[ib] = __builtin_amdgcn_mfma_f32_16x16x32_bf16(ak, tb, aw[ib], 0, 0, 0); aw[ib] = __builtin_amdgcn_mfma_f32_16x16x32_bf16(akl, tb, aw[ib], 0, 0, 0); aw[ib] = __builtin_amdgcn_mfma_f32_16x16x32_bf16(ak, tl, aw[ib], 0, 0, 0); } }
          float* U = (float*)(p.ws + WS_GU) + (size_t)item * 8192; bf16_t* W = (bf16_t*)(p.ws + WS_GW) + (size_t)item * 8192;
#pragma unroll
          for (int ib = 0; ib < 4; ++ib) { const int i = 16 * ib + fr, d0 = 16 * w + 4 * fq;
              *(f32x4*)(U + i * 128 + d0) = au[ib];
              *(u32x2*)(W + i * 128 + d0) = (u32x2){cvt_pk_bf16(aw[ib][0], aw[ib][1]), cvt_pk_bf16(aw[ib][2], aw[ib][3])}; } }
        lds_barrier();
    }
    __syncthreads();
}
__device__ __forceinline__ void gdn_chunk_item(const Params& p, LAS unsigned char* lds, int bh, int sl) {
    const int tid = otid(), w = tid >> 6, lane = tid & 63, fr = lane & 15, fq = lane >> 4;
    const int b = bh >> 4, h = bh & 15, row0 = b * SEQ;
    LAS bf16_t* w_s = (LAS bf16_t*)lds; LAS bf16_t* qg_s = w_s + 64 * 136; LAS bf16_t* ke_s = qg_s + 64 * 136; LAS bf16_t* qkm_s = ke_s + 128 * 72; LAS bf16_t* ST_s = qkm_s + 64 * 72; LAS bf16_t* vnT_s = ST_s + 32 * 136;
    const bf16_t* W = (const bf16_t*)(p.ws + WS_GW) + (size_t)bh * 32 * 8192; const bf16_t* QG = (const bf16_t*)(p.ws + WS_GQG) + (size_t)bh * 32 * 8192;
    const bf16_t* KE = (const bf16_t*)(p.ws + WS_GKE) + (size_t)bh * 32 * 8192; const bf16_t* QKM = (const bf16_t*)(p.ws + WS_GQKM) + (size_t)bh * 32 * 4096;
    const float* U = (const float*)(p.ws + WS_GU) + (size_t)bh * 32 * 8192; const float* EG = (const float*)(p.ws + WS_GEG) + bh * 32;
    float* OB = (float*)(p.ws + WS_OB);
    for (int e = tid; e < 32 * 136 / 8; e += 512) ((LAS u32x4*)ST_s)[e] = (u32x4){0, 0, 0, 0};
    f32x4 S[2]; S[0] = (f32x4){0.f, 0.f, 0.f, 0.f}; S[1] = S[0];
    const int tb = w >> 1, db = w & 1;
    struct Regs { u32x4 rw[2], rq[2], rk[2], rm; f32x4 ru; float reg; };
    auto load_regs = [&](Regs& R, int c) {
#pragma unroll
        for (int i = 0; i < 2; ++i) { const int e = tid + 512 * i; R.rw[i] = *(const u32x4*)(W + (size_t)c * 8192 + e * 8); R.rq[i] = *(const u32x4*)(QG + (size_t)c * 8192 + e * 8); R.rk[i] = *(const u32x4*)(KE + (size_t)c * 8192 + e * 8); }
        R.rm = *(const u32x4*)(QKM + (size_t)c * 4096 + tid * 8);
#pragma unroll
        for (int r = 0; r < 4; ++r) R.ru[r] = U[(size_t)c * 8192 + (16 * tb + 4 * fq + r) * 128 + sl * 32 + 16 * db + fr];
        R.reg = EG[c];
    };
    auto step = [&](Regs& R, int c) {
#pragma unroll
        for (int i = 0; i < 2; ++i) { const int e = tid + 512 * i;
            *(LAS u32x4*)(w_s + (e >> 4) * 136 + (e & 15) * 8) = R.rw[i]; *(LAS u32x4*)(qg_s + (e >> 4) * 136 + (e & 15) * 8) = R.rq[i];
            *(LAS u32x4*)(ke_s + (e >> 3) * 72 + (e & 7) * 8) = R.rk[i]; }
        *(LAS u32x4*)(qkm_s + (tid >> 3) * 72 + (tid & 7) * 8) = R.rm;
        const f32x4 ucur = R.ru; const float eg = R.reg;
        lds_barrier();
        load_regs(R, c + 2 < 32 ? c + 2 : 31);
        { f32x4 acc = (f32x4){0.f, 0.f, 0.f, 0.f};
#pragma unroll
          for (int kk = 0; kk < 4; ++kk) acc = __builtin_amdgcn_mfma_f32_16x16x32_bf16(*(const LAS bf16x8*)(w_s + (16 * tb + fr) * 136 + kk * 32 + 8 * fq), *(const LAS bf16x8*)(ST_s + (16 * db + fr) * 136 + kk * 32 + 8 * fq), acc, 0, 0, 0);
          const f32x4 vn = ucur - acc;
          *(LAS u32x2*)(vnT_s + (16 * db + fr) * 72 + 16 * tb + 4 * fq) = (u32x2){cvt_pk_bf16(vn[0], vn[1]), cvt_pk_bf16(vn[2], vn[3])}; }
        lds_barrier();
        { f32x4 acc = (f32x4){0.f, 0.f, 0.f, 0.f};
#pragma unroll
          for (int kk = 0; kk < 4; ++kk) acc = __builtin_amdgcn_mfma_f32_16x16x32_bf16(*(const LAS bf16x8*)(qg_s + (16 * tb + fr) * 136 + kk * 32 + 8 * fq), *(const LAS bf16x8*)(ST_s + (16 * db + fr) * 136 + kk * 32 + 8 * fq), acc, 0, 0, 0);
#pragma unroll
          for (int kk = 0; kk < 2; ++kk) acc = __builtin_amdgcn_mfma_f32_16x16x32_bf16(*(const LAS bf16x8*)(qkm_s + (16 * tb + fr) * 72 + kk * 32 + 8 * fq), *(const LAS bf16x8*)(vnT_s + (16 * db + fr) * 72 + kk * 32 + 8 * fq), acc, 0, 0, 0);
#pragma unroll
          for (int r = 0; r < 4; ++r) OB[(size_t)(row0 + c * 64 + 16 * tb + 4 * fq + r) * D + h * 128 + sl * 32 + 16 * db + fr] = acc[r]; }
#pragma unroll
        for (int n = 0; n < 2; ++n) { S[n] *= eg;
#pragma unroll
            for (int kk = 0; kk < 2; ++kk) S[n] = __builtin_amdgcn_mfma_f32_16x16x32_bf16(*(const LAS bf16x8*)(ke_s + (16 * w + fr) * 72 + kk * 32 + 8 * fq), *(const LAS bf16x8*)(vnT_s + (16 * n + fr) * 72 + kk * 32 + 8 * fq), S[n], 0, 0, 0); }
        lds_barrier();
#pragma unroll
        for (int n = 0; n < 2; ++n) *(LAS u32x2*)(ST_s + (16 * n + fr) * 136 + 16 * w + 4 * fq) = (u32x2){cvt_pk_bf16(S[n][0], S[n][1]), cvt_pk_bf16(S[n][2], S[n][3])};
    };
    Regs RA, RB;
    load_regs(RA, 0); load_regs(RB, 1);
    for (int c = 0; c < 32; c += 2) { step(RA, c); step(RB, c + 1); }
    float* so = p.out + O_GDN_P + (size_t)bh * 16384;
#pragma unroll
    for (int n = 0; n < 2; ++n)
#pragma unroll
        for (int r = 0; r < 4; ++r) so[(size_t)(16 * w + 4 * fq + r) * 128 + sl * 32 + 16 * n + fr] = S[n][r];
    __syncthreads();
}

__device__ __forceinline__ void gla_chunk_item(const Params& p, LAS unsigned char* lds, int bh, int sl) {
    const int tid = otid(), w = tid >> 6, lane = tid & 63, fr = lane & 15, fq = lane >> 4;
    const int b = bh >> 2, h = bh & 3, row0 = b * SEQ;
    LAS bf16_t* qd_s = (LAS bf16_t*)lds; LAS bf16_t* keT_s = qd_s + 64 * 264; LAS bf16_t* att_s = keT_s + 256 * 72; LAS bf16_t* vT_s = att_s + 64 * 72; LAS bf16_t* ST_s = vT_s + 64 * 72;
    LAS float* E_s = (LAS float*)(ST_s + 64 * 264);
    const bf16_t* P = (const bf16_t*)(p.ws + WS_P);
    const bf16_t* QD = (const bf16_t*)(p.ws + WS_QD) + (size_t)bh * 32 * 16384; const bf16_t* KET = (const bf16_t*)(p.ws + WS_KET) + (size_t)bh * 32 * 16384;
    const bf16_t* ATT = (const bf16_t*)(p.ws + WS_ATT) + (size_t)bh * 32 * 4096; const float* Eg = (const float*)(p.ws + WS_E) + (size_t)bh * 32 * 256;
    float* OA = (float*)(p.ws + WS_OA);
    for (int e = tid; e < 64 * 264 / 8; e += 512) ((LAS u32x4*)ST_s)[e] = (u32x4){0, 0, 0, 0};
    f32x4 S[2][4];
#pragma unroll
    for (int a = 0; a < 2; ++a)
#pragma unroll
        for (int n = 0; n < 4; ++n) S[a][n] = (f32x4){0.f, 0.f, 0.f, 0.f};
    u32x4 rqd[4], rke[4], ratt, rv; f32x4 rE;
    auto load_regs = [&](int c) {
#pragma unroll
        for (int i = 0; i < 4; ++i) { const int e = tid + 512 * i; rqd[i] = *(const u32x4*)(QD + (size_t)c * 16384 + e * 8); rke[i] = *(const u32x4*)(KET + (size_t)c * 16384 + e * 8); }
        ratt = *(const u32x4*)(ATT + (size_t)c * 4096 + tid * 8);
        rv = *(const u32x4*)(P + (size_t)(row0 + c * 64 + (tid >> 3)) * N1 + C_VA + h * 512 + sl * 64 + (tid & 7) * 8);
        if (tid < 64) rE = *(const f32x4*)(Eg + c * 256 + tid * 4);
    };
    load_regs(0);
    const int ib = w >> 1, dv2 = (w & 1) * 2;
    for (int c = 0; c < 32; ++c) {
#pragma unroll
        for (int i = 0; i < 4; ++i) { const int e = tid + 512 * i;
            *(LAS u32x4*)(qd_s + (e >> 5) * 264 + (e & 31) * 8) = rqd[i];
            *(LAS u32x4*)(keT_s + (e >> 3) * 72 + (e & 7) * 8) = rke[i]; }
        *(LAS u32x4*)(att_s + (tid >> 3) * 72 + (tid & 7) * 8) = ratt;
        { const int t = tid >> 3, d0 = (tid & 7) * 8;
          vT_s[(d0 + 0) * 72 + t] = (bf16_t)(rv.x & 0xffffu); vT_s[(d0 + 1) * 72 + t] = (bf16_t)(rv.x >> 16);
          vT_s[(d0 + 2) * 72 + t] = (bf16_t)(rv.y & 0xffffu); vT_s[(d0 + 3) * 72 + t] = (bf16_t)(rv.y >> 16);
          vT_s[(d0 + 4) * 72 + t] = (bf16_t)(rv.z & 0xffffu); vT_s[(d0 + 5) * 72 + t] = (bf16_t)(rv.z >> 16);
          vT_s[(d0 + 6) * 72 + t] = (bf16_t)(rv.w & 0xffffu); vT_s[(d0 + 7) * 72 + t] = (bf16_t)(rv.w >> 16); }
        if (tid < 64) *(LAS f32x4*)(E_s + tid * 4) = rE;
        lds_barrier();
        load_regs(c + 1 < 32 ? c + 1 : 31);
        { f32x4 acc[2]; acc[0] = (f32x4){0.f, 0.f, 0.f, 0.f}; acc[1] = acc[0];
#pragma unroll
          for (int kk = 0; kk < 2; ++kk) { const bf16x8 a = *(const LAS bf16x8*)(att_s + (16 * ib + fr) * 72 + kk * 32 + 8 * fq);
#pragma unroll
              for (int n = 0; n < 2; ++n) { const bf16x8 bb = *(const LAS bf16x8*)(vT_s + (16 * (dv2 + n) + fr) * 72 + kk * 32 + 8 * fq); acc[n] = __builtin_amdgcn_mfma_f32_16x16x32_bf16(a, bb, acc[n], 0, 0, 0); } }
#pragma unroll
          for (int kk = 0; kk < 8; ++kk) { const bf16x8 a = *(const LAS bf16x8*)(qd_s + (16 * ib + fr) * 264 + kk * 32 + 8 * fq);
#pragma unroll
              for (int n = 0; n < 2; ++n) { const bf16x8 bb = *(const LAS bf16x8*)(ST_s + (16 * (dv2 + n) + fr) * 264 + kk * 32 + 8 * fq); acc[n] = __builtin_amdgcn_mfma_f32_16x16x32_bf16(a, bb, acc[n], 0, 0, 0); } }
#pragma unroll
          for (int n = 0; n < 2; ++n)
#pragma unroll
              for (int r = 0; r < 4; ++r) OA[(size_t)(row0 + c * 64 + 16 * ib + 4 * fq + r) * D + h * 512 + sl * 64 + 16 * (dv2 + n) + fr] = acc[n][r] * 0.0625f; }
#pragma unroll
        for (int a = 0; a < 2; ++a) { const f32x4 e4 = *(const LAS f32x4*)(E_s + 16 * (2 * w + a) + 4 * fq);
#pragma unroll
            for (int n = 0; n < 4; ++n) S[a][n] *= e4; }
#pragma unroll
        for (int kk = 0; kk < 2; ++kk) {
            bf16x8 bv[4];
#pragma unroll
            for (int n = 0; n < 4; ++n) bv[n] = *(const LAS bf16x8*)(vT_s + (16 * n + fr) * 72 + kk * 32 + 8 * fq);
#pragma unroll
            for (int a = 0; a < 2; ++a) { const bf16x8 ak = *(const LAS bf16x8*)(keT_s + (16 * (2 * w + a) + fr) * 72 + kk * 32 + 8 * fq);
#pragma unroll
                for (int n = 0; n < 4; ++n) S[a][n] = __builtin_amdgcn_mfma_f32_16x16x32_bf16(ak, bv[n], S[a][n], 0, 0, 0); } }
        lds_barrier();
#pragma unroll
        for (int a = 0; a < 2; ++a)
#pragma unroll
            for (int n = 0; n < 4; ++n) *(LAS u32x2*)(ST_s + (16 * n + fr) * 264 + 16 * (2 * w + a) + 4 * fq) = (u32x2){cvt_pk_bf16(S[a][n][0], S[a][n][1]), cvt_pk_bf16(S[a][n][2], S[a][n][3])};
    }
    float* so = p.out + O_GLA_P + (size_t)bh * 131072;
#pragma unroll
    for (int a = 0; a < 2; ++a)
#pragma unroll
        for (int n = 0; n < 4; ++n)
#pragma unroll
            for (int r = 0; r < 4; ++r) so[(size_t)(16 * (2 * w + a) + 4 * fq + r) * 512 + sl * 64 + 16 * n + fr] = S[a][n][r];
    __syncthreads();
}
__device__ __forceinline__ void phase3(const Params& p, LAS unsigned char* lds) {
    constexpr int nA = 256, nB = 128, nC = 512, nD = 2048;
    for (int it = blockIdx.x; it < nA + nB; it += gridDim.x) {
        int r = it;
        if (r < nA) { gdn_prep_item(p, lds, r >> 2, r & 3); continue; } r -= nA;
        { const int xcd = r & 7, idx = r >> 3; gla_chunk_item(p, lds, xcd * 2 + (idx >> 3), idx & 7); }
    }
    unsigned* ctr = (unsigned*)(p.ws + WS_BAR) + 64;
    volatile LAS unsigned* slot = (volatile LAS unsigned*)(lds + 131072 + 16);
    unsigned nxt = 0u;
    if (threadIdx.x == 0) nxt = __hip_atomic_fetch_add(ctr, 1u, __ATOMIC_RELAXED, __HIP_MEMORY_SCOPE_AGENT);
    for (int k = 0;; ++k) {
        if (threadIdx.x == 0) slot[k & 1] = nxt;
        __syncthreads();
        const int r = (int)slot[k & 1];
        if (r >= nC + nD) break;
        if (threadIdx.x == 0) nxt = __hip_atomic_fetch_add(ctr, 1u, __ATOMIC_RELAXED, __HIP_MEMORY_SCOPE_AGENT);
        if (r < nC) gla_sample_item(p, lds, r >> 2, r & 3); else gdn_sample_item(p, lds, (r - nC) >> 4, (r - nC) & 15);
    }
}
__device__ __forceinline__ void phase3b(const Params& p, LAS unsigned char* lds) {
    for (int it = blockIdx.x; it < 256; it += gridDim.x) { const int xcd = it & 7, idx = it >> 3; gdn_chunk_item(p, lds, xcd * 8 + (idx >> 2), idx & 3); }
}

__device__ __forceinline__ void phase4(const Params& p) {
    const int tid_ = otid(), lane = tid_ & 63, wave = tid_ >> 6;
    const int gw = blockIdx.x * 8 + wave, NGW = gridDim.x * 8;
    const bf16_t* P = (const bf16_t*)(p.ws + WS_P);
    const float* OA = (const float*)(p.ws + WS_OA); const float* OB = (const float*)(p.ws + WS_OB);
    bf16_t* OAN = (bf16_t*)(p.ws + WS_OAN); bf16_t* OBN = (bf16_t*)(p.ws + WS_OBN);
    for (int it = gw; it < (NT / 4) * 8; it += NGW) {
        const int tq = it >> 3, sub = it & 7;
        const bool isA = sub < 4;
        const int c0 = (isA ? sub : sub - 4) * 512 + lane * 8;
        const float* src = (isA ? OA : OB) + c0; bf16_t* dst = (isA ? OAN : OBN) + c0;
        const float* gn = isA ? p.gla_norm_g + lane * 8 : p.gdn_norm_g + (lane & 15) * 8;
        const f32x4 g0 = *(const f32x4*)gn, g1 = *(const f32x4*)(gn + 4);
        f32x4 a[4], b[4]; u32x4 gw4[4];
#pragma unroll
        for (int u = 0; u < 4; ++u) { const size_t tok = (size_t)(tq * 4 + u);
            a[u] = *(const f32x4*)(src + tok * D); b[u] = *(const f32x4*)(src + tok * D + 4);
            gw4[u] = *(const u32x4*)(P + tok * N1 + (isA ? C_GA : C_GB) + c0); }
#pragma unroll
        for (int u = 0; u < 4; ++u) { const size_t tok = (size_t)(tq * 4 + u);
            float ss = (a[u][0] * a[u][0] + a[u][1] * a[u][1]) + (a[u][2] * a[u][2] + a[u][3] * a[u][3]) + (b[u][0] * b[u][0] + b[u][1] * b[u][1]) + (b[u][2] * b[u][2] + b[u][3] * b[u][3]);
            ss += dpp<0xB1>(ss); ss += dpp<0x4E>(ss); ss += dpp<0x141>(ss); ss += dpp<0x140>(ss);
            float inv;
            if (isA) inv = rsqrtf(xrow16_sum(ss) * (1.0f / 512.0f) + EPS); else inv = rsqrtf(ss * (1.0f / 128.0f) + EPS);
            u32x4 o;
            o.x = cvt_pk_bf16(a[u][0] * inv * g0[0] * siluf_(bf_lo(gw4[u].x)), a[u][1] * inv * g0[1] * siluf_(bf_hi(gw4[u].x)));
            o.y = cvt_pk_bf16(a[u][2] * inv * g0[2] * siluf_(bf_lo(gw4[u].y)), a[u][3] * inv * g0[3] * siluf_(bf_hi(gw4[u].y)));
            o.z = cvt_pk_bf16(b[u][0] * inv * g1[0] * siluf_(bf_lo(gw4[u].z)), b[u][1] * inv * g1[1] * siluf_(bf_hi(gw4[u].z)));
            o.w = cvt_pk_bf16(b[u][2] * inv * g1[2] * siluf_(bf_lo(gw4[u].w)), b[u][3] * inv * g1[3] * siluf_(bf_hi(gw4[u].w)));
            *(u32x4*)(dst + tok * D) = o; }
    }
}

__device__ __forceinline__ void phase7(const Params& p) {
    const int tid_ = otid(), lane = tid_ & 63, wave = tid_ >> 6;
    const int gw = blockIdx.x * 8 + wave, NGW = gridDim.x * 8;
    for (int row = gw; row < NT; row += NGW) {
        float* xr = p.out + O_Y + (size_t)row * D;
        f32x4 v[8]; float ss = 0.f;
#pragma unroll
        for (int j = 0; j < 8; ++j) { v[j] = *(const f32x4*)(xr + j * 256 + lane * 4); ss += (v[j][0] * v[j][0] + v[j][1] * v[j][1]) + (v[j][2] * v[j][2] + v[j][3] * v[j][3]); }
        const float inv = rsqrtf(wave_sum_fast(ss) * (1.0f / D) + EPS);
#pragma unroll
        for (int j = 0; j < 8; ++j) { const f32x4 g = *(const f32x4*)(p.final_norm_g + j * 256 + lane * 4); __builtin_nontemporal_store(v[j] * inv * g, (f32x4*)(xr + j * 256 + lane * 4)); }
    }
}

#ifndef PH_LO
#define PH_LO 0
#endif
#ifndef PH_HI
#define PH_HI 8
#endif
#ifndef GEMM_SP2
#define GEMM_SP2 true
#endif
#ifndef GEMM_ALIGN
#define GEMM_ALIGN true
#endif
extern __shared__ __attribute__((aligned(16))) unsigned char shm[];
__global__ void __launch_bounds__(512, 2) fwd_megakernel(Params p) {
    cg::grid_group grid = cg::this_grid();
    LAS unsigned char* lds = (LAS unsigned char*)shm;
    const int G = gridDim.x, c = blockIdx.x;
    unsigned* bar = (unsigned*)(p.ws + WS_BAR);
    volatile LAS unsigned* st = (volatile LAS unsigned*)(lds + 131072);
    if (threadIdx.x < 2) st[threadIdx.x] = 0u;
    if (blockIdx.x == 0) for (int i = threadIdx.x; i < 8192; i += 512) bar[i] = 0u;
    __syncthreads();
    grid.sync();
    const XcdBarrier xb = xcd_barrier_post(bar, st);
    phase0(p, lds);
    xcd_barrier(xb);
    { pg8::Gemm g; g.A0 = g.A1 = (const bf16_t*)(p.ws + WS_H); g.Bt0 = g.Bt1 = (const bf16_t*)(p.ws + WS_W1T); g.M = NT; g.N = N1; g.K = D;
      pg8::StaticOrder S; S.init(NT, N1, G, c); pg8::EpiP E; E.O = (bf16_t*)(p.ws + WS_P);
      pg8::gemm_phase<GEMM_SP2, GEMM_ALIGN>(lds, g, S, E); }
    xcd_barrier(xb);
    phase2(p, lds);
    xcd_barrier(xb);
    phase3(p, lds);
    xcd_barrier(xb);
    phase3b(p, lds);
    xcd_barrier(xb);
    phase4(p);
    xcd_barrier(xb);
    { pg8::Gemm g; g.A0 = (const bf16_t*)(p.ws + WS_OAN); g.A1 = (const bf16_t*)(p.ws + WS_OBN); g.Bt0 = (const bf16_t*)(p.ws + WS_WAT); g.Bt1 = (const bf16_t*)(p.ws + WS_WBT); g.M = NT; g.N = D; g.K = D;
      pg8::PairOrder S; S.init(NT, D, G, c); pg8::EpiGate E; E.P = (const bf16_t*)(p.ws + WS_P); E.YT = (float*)(p.ws + WS_YT); E.MRG = (bf16_t*)(p.ws + WS_MRG); E.flags = (unsigned*)(p.ws + WS_BAR) + 4096;
      pg8::gemm_phase<GEMM_SP2, GEMM_ALIGN>(lds, g, S, E); }
    xcd_barrier(xb);
    { pg8::Gemm g; g.A0 = g.A1 = (const bf16_t*)(p.ws + WS_MRG); g.Bt0 = g.Bt1 = (const bf16_t*)(p.ws + WS_WOT); g.M = NT; g.N = D; g.K = D;
      pg8::StaticOrder S; S.init(NT, D, G, c); pg8::EpiOut E; E.xp = p.x_prompt; E.xs = p.x_sample; E.O = p.out + O_Y;
      pg8::gemm_phase<GEMM_SP2, GEMM_ALIGN>(lds, g, S, E); }
    xcd_barrier(xb);
    phase7(p);
}

extern "C" void kernel_launch(void* const* d_in, const int* in_sizes, int n_in, void* d_out, int out_size, void* d_ws, size_t ws_size, hipStream_t stream) {
    static int grid_blocks = 0;
    if (grid_blocks == 0) {
        if (n_in != 18 || ws_size < WS_END) { fprintf(stderr, "kernel_launch: unexpected n_in %d / ws_size %zu (need %zu)\n", n_in, ws_size, (size_t)WS_END); grid_blocks = -1; return; }
        int dev = 0, cus = 0, per_cu = 0;
        (void)hipGetDevice(&dev);
        (void)hipDeviceGetAttribute(&cus, hipDeviceAttributeMultiprocessorCount, dev);
        if (hipFuncSetAttribute((const void*)fwd_megakernel, hipFuncAttributeMaxDynamicSharedMemorySize, LDS_BYTES) != hipSuccess) fprintf(stderr, "kernel_launch: hipFuncSetAttribute failed\n");
        (void)hipOccupancyMaxActiveBlocksPerMultiprocessor(&per_cu, (const void*)fwd_megakernel, 512, LDS_BYTES);
        if (per_cu < 1) { fprintf(stderr, "kernel_launch: occupancy query says %d blocks per CU\n", per_cu); per_cu = 1; }
        if (per_cu > 1) per_cu = 1;
        grid_blocks = cus * per_cu;
        (void)hipGetLastError();
    }
    if (grid_blocks < 0) return;
    Params p{};
    p.x_prompt = (const float*)d_in[0]; p.x_sample = (const float*)d_in[1]; p.state_gla = (const float*)d_in[2]; p.state_gdn = (const float*)d_in[3]; p.state_conv = (const float*)d_in[4];
    p.ln_in_g = (const float*)d_in[5]; p.w_in = (const float*)d_in[6]; p.w_alpha2 = (const float*)d_in[7]; p.b_alpha = (const float*)d_in[8]; p.conv_w = (const float*)d_in[9];
    p.a_log = (const float*)d_in[10]; p.dt_bias = (const float*)d_in[11]; p.gla_norm_g = (const float*)d_in[12]; p.gdn_norm_g = (const float*)d_in[13];
    p.w_br_a = (const float*)d_in[14]; p.w_br_b = (const float*)d_in[15]; p.w_out = (const float*)d_in[16]; p.final_norm_g = (const float*)d_in[17];
    p.out = (float*)d_out; p.ws = (unsigned char*)d_ws;
    void* args[] = {&p};
    hipError_t e = hipLaunchCooperativeKernel((const void*)fwd_megakernel, dim3(grid_blocks), dim3(512), args, LDS_BYTES, stream);
    if (e != hipSuccess) fprintf(stderr, "cooperative launch failed: %s (grid %d)\n", hipGetErrorString(e), grid_blocks);
}
```

```cpp
#include <hip/hip_runtime.h>
#include <hip/hip_cooperative_groups.h>
#include <cstdio>
#include <cstdint>
namespace cg = cooperative_groups;

#define LAS __attribute__((address_space(3)))
typedef unsigned short bf16_t;
typedef unsigned int u32;
typedef short bf16x8 __attribute__((ext_vector_type(8)));
typedef float f32x4 __attribute__((ext_vector_type(4)));
typedef float f32x2 __attribute__((ext_vector_type(2)));
typedef u32 u32x4 __attribute__((ext_vector_type(4)));
typedef u32 u32x2 __attribute__((ext_vector_type(2)));

constexpr int D = 2048, NTP = 8192, NTS = 1024, NT = NTP + NTS, SEQ = 2048, DSEQ = 8;
constexpr int DIN = 18480, N1 = 18688;
constexpr int C_QA = 0, C_KA = 1024, C_VA = 2048, C_GA = 4096, C_QKVB = 6144, C_GB = 12288, C_MA = 14336, C_MB = 16384, C_LR = 18432, C_BETA = 18448, C_DEC = 18464;
constexpr float EPS = 1e-6f;
constexpr size_t O_Y = 0, O_GLA_P = 18874368, O_GDN_P = 20971520, O_CONV_P = 22020096, O_GLA_S = 22093824, O_GDN_S = 89202688, O_CONV_S = 122757120;
constexpr size_t WS_H = 0, WS_W1T = WS_H + (size_t)NT * D * 2, WS_WAT = WS_W1T + (size_t)N1 * D * 2, WS_WBT = WS_WAT + (size_t)D * D * 2, WS_WOT = WS_WBT + (size_t)D * D * 2,
                 WS_P = WS_WOT + (size_t)D * D * 2, WS_ALPHA = WS_P + (size_t)NT * N1 * 2, WS_QB = WS_ALPHA + (size_t)NT * 1024 * 4, WS_KB = WS_QB + (size_t)NT * D * 4,
                 WS_VB = WS_KB + (size_t)NT * D * 4, WS_BETA = WS_VB + (size_t)NT * D * 4, WS_GA = WS_BETA + (size_t)NT * 16 * 4, WS_OA = WS_GA + (size_t)NT * 16 * 4,
                 WS_OB = WS_OA + (size_t)NT * D * 4, WS_ATT = WS_OB + (size_t)NT * D * 4, WS_E = WS_ATT + (size_t)512 * 4096 * 2, WS_GQKM = WS_E + (size_t)512 * 256 * 4, WS_GU = WS_GQKM + (size_t)2048 * 4096 * 2, WS_GT = WS_GU + (size_t)2048 * 8192 * 4, WS_GEG = WS_GT + (size_t)2048 * 4096 * 4, WS_BAR = WS_GEG + (size_t)2048 * 4, WS_GL = WS_BAR + (size_t)65536, WS_END = WS_GL + (size_t)NT * 16 * 4;
constexpr size_t WS_GW = WS_H, WS_GQG = WS_GW + (size_t)2048 * 8192 * 2, WS_GKE = WS_GQG + (size_t)2048 * 8192 * 2;
static_assert(WS_GKE + (size_t)2048 * 8192 * 2 <= WS_WAT, "overlay3");
constexpr size_t WS_QD = WS_ALPHA, WS_KET = WS_QD + (size_t)512 * 16384 * 2;
static_assert(WS_KET + (size_t)512 * 16384 * 2 <= WS_ALPHA + (size_t)NTP * 1024 * 4, "overlay2");
constexpr size_t WS_OAN = WS_H, WS_OBN = WS_OAN + (size_t)NT * D * 2, WS_MRG = WS_OBN + (size_t)NT * D * 2, WS_YT = WS_QB;
static_assert(WS_MRG + (size_t)NT * D * 2 <= WS_WAT, "overlay");
constexpr int LDS_BYTES = 131072 + 64;

struct Params {
    const float *x_prompt, *x_sample, *state_gla, *state_gdn, *state_conv, *ln_in_g, *w_in, *w_alpha2, *b_alpha, *conv_w, *a_log, *dt_bias, *gla_norm_g, *gdn_norm_g, *w_br_a, *w_br_b, *w_out, *final_norm_g;
    float* out;
    unsigned char* ws;
};

__device__ __forceinline__ u32 cvt_pk_bf16(float lo, float hi) { u32 r; asm volatile("v_cvt_pk_bf16_f32 %0, %1, %2" : "=v"(r) : "v"(lo), "v"(hi)); return r; }
__device__ __forceinline__ float bf_lo(u32 w) { return __uint_as_float(w << 16); }
__device__ __forceinline__ float bf_hi(u32 w) { return __uint_as_float(w & 0xffff0000u); }
__device__ __forceinline__ float bf1(bf16_t h) { return __uint_as_float(((u32)h) << 16); }
__device__ __forceinline__ float wave_sum(float v) {
#pragma unroll
    for (int o = 1; o < 64; o <<= 1) v += __shfl_xor(v, o);
    return v;
}
template <int CTRL> __device__ __forceinline__ float dpp(float x) { return __builtin_bit_cast(float, __builtin_amdgcn_mov_dpp(__builtin_bit_cast(int, x), CTRL, 0xf, 0xf, true)); }
constexpr int ROR8 = 0x128, ROR4 = 0x124;
__device__ __forceinline__ float xrow16_sum(float x) {
    auto s = __builtin_amdgcn_permlane16_swap(__float_as_uint(x), __float_as_uint(x), false, false);
    x = __uint_as_float(s[0]) + __uint_as_float(s[1]);
    auto t = __builtin_amdgcn_permlane32_swap(__float_as_uint(x), __float_as_uint(x), false, false);
    return __uint_as_float(t[0]) + __uint_as_float(t[1]);
}
__device__ __forceinline__ float wave_sum_fast(float x) {
    x += dpp<0xB1>(x); x += dpp<0x4E>(x); x += dpp<0x141>(x); x += dpp<0x140>(x);
    return xrow16_sum(x);
}
__device__ __forceinline__ float sigmoidf_(float x) { return __builtin_amdgcn_rcpf(1.0f + __expf(-x)); }
__device__ __forceinline__ float siluf_(float x) { return x * sigmoidf_(x); }
__device__ __forceinline__ float softplusf_(float x) { return fmaxf(x, 0.f) + log1pf(expf(-fabsf(x))); }
__device__ __forceinline__ int otid() { int t = threadIdx.x; asm volatile("" : "+v"(t)); return t; }
__device__ __forceinline__ void lds_barrier() { asm volatile("s_waitcnt lgkmcnt(0)" ::: "memory"); __builtin_amdgcn_s_barrier(); asm volatile("" ::: "memory"); }
#define LDS_WAIT() asm volatile("s_waitcnt lgkmcnt(0)" ::: "memory")

#define XB_TMO      128
#define XB_XCNT(j)  (256  + 64 * (j))
#define XB_XSUB(j)  (1280 + 64 * (j))
#define XB_XGEN(j)  (2304 + 64 * (j))
#define XB_TOP      3328
#define XB_TOPGEN   3392
#define XCD_BAR_WORDS 3456
#define XB_SPIN_CAP (1u << 18)
__device__ __forceinline__ unsigned xb_ld(unsigned* p)              { return __hip_atomic_load(p, __ATOMIC_RELAXED, __HIP_MEMORY_SCOPE_AGENT); }
__device__ __forceinline__ unsigned xb_add(unsigned* p, unsigned v) { return __hip_atomic_fetch_add(p, v, __ATOMIC_RELAXED, __HIP_MEMORY_SCOPE_AGENT); }
__device__ __forceinline__ unsigned xb_xcc_id() { return (unsigned)__builtin_amdgcn_s_getreg((3 << 11) | 20) & 0xFu; }
#define XB_SPIN(cond, bar) do { unsigned _sp = 0; while (cond) { __builtin_amdgcn_s_sleep(1); \
    if ((++_sp & 255u) == 0u) { if (xb_ld(&(bar)[XB_TMO])) break; if (_sp > XB_SPIN_CAP) { atomicAdd(&(bar)[XB_TMO], 1u); break; } } } } while (0)
struct XcdBarrier { unsigned* bar; unsigned x; volatile LAS unsigned* st; };
__device__ __forceinline__ XcdBarrier xcd_barrier_post(unsigned* bar, volatile LAS unsigned* st) {
    XcdBarrier b; b.bar = bar; b.x = xb_xcc_id(); b.st = st;
    if (threadIdx.x == 0) (void)xb_add(&bar[XB_XCNT(b.x)], 1u);
    return b;
}
__device__ __forceinline__ void xcd_barrier_complete(unsigned* bar, unsigned x, unsigned& nloc, unsigned& nx) {
    const unsigned G = gridDim.x * gridDim.y * gridDim.z;
    unsigned sum, cnt, mine, sp = 0u;
    for (;;) {
        sum = 0u; cnt = 0u; mine = 0u;
#pragma unroll
        for (unsigned j = 0; j < 16; ++j) { const unsigned c = xb_ld(&bar[XB_XCNT(j)]); sum += c; cnt += (c > 0u) ? 1u : 0u; mine = (j == x) ? c : mine; }
        if (sum == G) break;
        __builtin_amdgcn_s_sleep(1);
        if ((++sp & 255u) == 0u) { if (xb_ld(&bar[XB_TMO])) break; if (sp > XB_SPIN_CAP) { atomicAdd(&bar[XB_TMO], 1u); break; } }
    }
    nloc = mine > 0u ? mine : 1u; nx = cnt > 0u ? cnt : 1u;
}
__device__ __forceinline__ void xcd_barrier(const XcdBarrier& b) {
    asm volatile("s_waitcnt vmcnt(0)" ::: "memory");
    __syncthreads();
    if (threadIdx.x == 0) {
        unsigned* bar = b.bar;
        __builtin_amdgcn_s_waitcnt(0);
        unsigned nloc = b.st[0], nx = b.st[1];
        if (nloc == 0u) { xcd_barrier_complete(bar, b.x, nloc, nx); b.st[0] = nloc; b.st[1] = nx; }
        const unsigned old = xb_add(&bar[XB_XSUB(b.x)], 1u);
        const unsigned gen = old / nloc;
        if (old + 1u == (gen + 1u) * nloc) {
            __builtin_amdgcn_fence(__ATOMIC_RELEASE, "agent");
            asm volatile("s_waitcnt vmcnt(0)" ::: "memory");
            const unsigned og = xb_add(&bar[XB_TOP], 1u);
            const unsigned tg = og / nx;
            if (og + 1u == (tg + 1u) * nx) xb_add(&bar[XB_TOPGEN], 1u);
            else XB_SPIN(xb_ld(&bar[XB_TOPGEN]) == tg, bar);
            __builtin_amdgcn_fence(__ATOMIC_ACQUIRE, "agent");
            xb_add(&bar[XB_XGEN(b.x)], 1u);
            asm volatile("s_waitcnt vmcnt(0)" ::: "memory");
        } else {
            XB_SPIN(xb_ld(&bar[XB_XGEN(b.x)]) == gen, bar);
            __builtin_amdgcn_fence(__ATOMIC_ACQUIRE, "agent");
            asm volatile("s_waitcnt vmcnt(0)" ::: "memory");
        }
    }
    __syncthreads();
}

namespace pg8 {
constexpr int BM = 256, BK = 64, HALF = 128, HTB = HALF * BK * 2, STAGE_BYTES = 8 * HTB, NXCD = 8, WGM = 8;
__device__ __forceinline__ int lds_byte(int r, int c) { const int st = (r >> 4) * 2 + (c >> 5), rr = r & 15, cc = c & 31, ob = rr * 64 + cc * 2; return st * 1024 + (ob ^ (((ob >> 9) & 1) << 5)); }
__device__ __forceinline__ void stage_rc(int b, int& R, int& C) { const int st = b / 1024, sb = b % 1024, swz = sb ^ (((sb >> 9) & 1) << 5); R = (st >> 1) * 16 + swz / 64; C = (st & 1) * 32 + (swz % 64) / 2; }
__device__ __forceinline__ int perm32(int rho) { const int n = rho >> 4, i = rho & 15; return 8 * (i >> 2) + 4 * n + (i & 3); }
struct Unit { int pm, pn, w, t; };
struct Gemm { const bf16_t *A0, *A1, *Bt0, *Bt1; int M, N, K; };
struct StaticOrder {
    int nM, nN, nwg, G, c;
    __device__ void init(int M, int N, int G_, int c_) { nM = M / BM; nN = N / BM; nwg = nM * nN; G = G_; c = c_; }
    __device__ bool next(int i, Unit& u) const { const long L = (long)i * G + c; if (L >= nwg) return false; map((int)L, u); return true; }
    __device__ void map(int L, Unit& u) const {
        int wgid = L; { const int q = nwg / NXCD, r = nwg % NXCD, xcd = wgid % NXCD, off = wgid / NXCD; wgid = (xcd < r ? xcd * (q + 1) : r * (q + 1) + (xcd - r) * q) + off; }
        const int nig = WGM * nN, gid = wgid / nig, fm = gid * WGM, gsz = (nM - fm) < WGM ? (nM - fm) : WGM;
        u.pm = fm + ((wgid % nig) % gsz); u.pn = (wgid % nig) / gsz; u.w = 0; u.t = 0;
    }
};
struct PairOrder : StaticOrder {
    __device__ bool next(int i, Unit& u) const {
        if (G != 256 || nwg != 288) { const bool ok = StaticOrder::next(i >> 1, u); u.w = i & 1; return ok; }
        if (i < 2) { map(c, u); u.w = i; return true; }
        if (i == 2 && c < 64) { const int t = c & 31; map(256 + t, u); u.w = 2 + (c >> 5); u.t = t; return true; }
        return false;
    }
};

template <bool SP2, bool ALIGN_EPI, class Epi, class Sched>
__device__ __forceinline__ void gemm_phase(LAS unsigned char* lds, const Gemm g, const Sched& S, const Epi& E) {
    const int tid = otid(), wid = __builtin_amdgcn_readfirstlane(tid >> 6), lane = tid & 63, wr = wid >> 2, wc = wid & 3, fr = lane & 15, fq = lane >> 4;
    const int K = g.K, nt = K / BK;
    unsigned voffA[2], voffB[2];
#pragma unroll
    for (int i = 0; i < 2; ++i) { int R, C; stage_rc(tid * 16 + i * 8192, R, C); const int Rb = Epi::PERM ? ((R & ~31) + perm32(R & 31)) : R;
        voffA[i] = (unsigned)(R * K + C) * 2u; voffB[i] = (unsigned)(Rb * K + C) * 2u; }
    const size_t kstep = (size_t)(BK * 2);
    const size_t hstep = (size_t)HALF * K * 2;
    const size_t tstep = 2 * hstep;
    const unsigned ldsw = (unsigned)wid * 1024u;
    const int aoff = lds_byte(wr * 64 + fr, fq * 8), boff = lds_byte(wc * 32 + fr, fq * 8);
#define PG8_SA(b, h) (((b) * 2 + (h)) * HTB)
#define PG8_SB(b, h) ((4 + (b) * 2 + (h)) * HTB)
#define PG8_STAGE(bufoff, gbase, voff) do { _Pragma("unroll") for (int _i = 0; _i < 2; ++_i) \
        __builtin_amdgcn_global_load_lds((const unsigned*)((const char*)(gbase) + (voff)[_i]), (LAS unsigned*)(lds + (bufoff) + ldsw + _i * 8192), 16, 0, 0); } while (0)
#define PG8_LDA(dst, b, h) do { _Pragma("unroll") for (int m = 0; m < 4; ++m) _Pragma("unroll") for (int k = 0; k < 2; ++k) dst[m][k] = *(const LAS bf16x8*)(lds + PG8_SA(b, h) + aoff + m * 2048 + k * 1024); } while (0)
#define PG8_LDB(dst, b, h) do { _Pragma("unroll") for (int n = 0; n < 2; ++n) _Pragma("unroll") for (int k = 0; k < 2; ++k) dst[n][k] = *(const LAS bf16x8*)(lds + PG8_SB(b, h) + boff + n * 2048 + k * 1024); } while (0)
#define PG8_MMA(ai, bj, At, Bt) do { __builtin_amdgcn_s_setprio(1); _Pragma("unroll") for (int m = 0; m < 4; ++m) _Pragma("unroll") for (int n = 0; n < 2; ++n) _Pragma("unroll") for (int k = 0; k < 2; ++k) \
        acc[ai][bj][m][n] = __builtin_amdgcn_mfma_f32_16x16x32_bf16(Bt[n][k], At[m][k], acc[ai][bj][m][n], 0, 0, 0); __builtin_amdgcn_s_setprio(0); } while (0)
#define PG8_WAIT_V(n) asm volatile("s_waitcnt vmcnt(" #n ")" ::: "memory")
#define PG8_WAIT_L(n) asm volatile("s_waitcnt lgkmcnt(" #n ")" ::: "memory")
#define PG8_BAR __builtin_amdgcn_s_barrier()
#define PG8_SCHED __builtin_amdgcn_sched_barrier(0)
    Unit cur, nxt; int ui = 0;
    if (!S.next(0, cur)) return;
    f32x4 acc[2][2][4][2];
#pragma unroll
    for (int a = 0; a < 2; ++a)
#pragma unroll
        for (int b = 0; b < 2; ++b)
#pragma unroll
            for (int m = 0; m < 4; ++m)
#pragma unroll
                for (int n = 0; n < 2; ++n) acc[a][b][m][n] = (f32x4){0.f, 0.f, 0.f, 0.f};
    bf16x8 At[4][2], B0[2][2], B1[2][2];
    const char* cA = (const char*)((cur.w & 1) ? g.A1 : g.A0) + (size_t)cur.pm * tstep; const char* cB = (const char*)((cur.w & 1) ? g.Bt1 : g.Bt0) + (size_t)cur.pn * tstep;
    if constexpr (SP2) {
        PG8_STAGE(PG8_SB(0, 0), cB, voffB); PG8_STAGE(PG8_SB(0, 1), cB + hstep, voffB); PG8_STAGE(PG8_SA(0, 0), cA, voffA); PG8_STAGE(PG8_SA(0, 1), cA + hstep, voffA);
        if (wr == 1) PG8_BAR;
        PG8_WAIT_V(2); PG8_BAR;
        PG8_STAGE(PG8_SB(1, 0), cB + kstep, voffB); PG8_STAGE(PG8_SA(1, 0), cA + kstep, voffA); PG8_STAGE(PG8_SB(1, 1), cB + hstep + kstep, voffB);
        PG8_WAIT_V(6); PG8_BAR;
    } else {
    PG8_STAGE(PG8_SB(0, 0), cB, voffB); PG8_STAGE(PG8_SA(0, 0), cA, voffA); PG8_STAGE(PG8_SB(0, 1), cB + hstep, voffB); PG8_STAGE(PG8_SA(0, 1), cA + hstep, voffA);
    if (wr == 1) PG8_BAR;
    PG8_WAIT_V(4); PG8_BAR;
    PG8_STAGE(PG8_SB(1, 0), cB + kstep, voffB); PG8_STAGE(PG8_SA(1, 0), cA + kstep, voffA); PG8_STAGE(PG8_SB(1, 1), cB + hstep + kstep, voffB);
    PG8_WAIT_V(6); PG8_BAR;
    }
    for (;;) {
        const bool has_next = S.next(ui + 1, nxt);
        const char* nA = has_next ? (const char*)((nxt.w & 1) ? g.A1 : g.A0) + (size_t)nxt.pm * tstep : cA; const char* nB = has_next ? (const char*)((nxt.w & 1) ? g.Bt1 : g.Bt0) + (size_t)nxt.pn * tstep : cB;
        for (int t = 0; t < nt; t += 2) {
            const bool last = (t == nt - 2);
            const char* a1 = cA + (size_t)(t + 1) * kstep;
            const char* a2 = last ? nA : cA + (size_t)(t + 2) * kstep; const char* b2 = last ? nB : cB + (size_t)(t + 2) * kstep;
            const char* a3 = a2 + kstep; const char* b3 = b2 + kstep;
            if constexpr (SP2) {
            PG8_LDB(B0, 0, 0); PG8_LDB(B1, 0, 1); PG8_SCHED; PG8_LDA(At, 0, 0); PG8_STAGE(PG8_SA(1, 1), a1 + hstep, voffA);
            PG8_WAIT_V(8); PG8_WAIT_L(0); PG8_BAR; PG8_MMA(0, 0, At, B0); PG8_MMA(0, 1, At, B1); PG8_BAR; PG8_SCHED;
            PG8_LDA(At, 0, 1); PG8_STAGE(PG8_SB(0, 0), b2, voffB); PG8_STAGE(PG8_SB(0, 1), b2 + hstep, voffB); PG8_STAGE(PG8_SA(0, 0), a2, voffA);
            PG8_WAIT_V(8); PG8_WAIT_L(0); PG8_BAR; PG8_MMA(1, 0, At, B0); PG8_MMA(1, 1, At, B1); PG8_BAR; PG8_SCHED;
            PG8_LDB(B0, 1, 0); PG8_LDB(B1, 1, 1); PG8_SCHED; PG8_LDA(At, 1, 0); PG8_STAGE(PG8_SA(0, 1), a2 + hstep, voffA);
            PG8_WAIT_V(8); PG8_WAIT_L(0); PG8_BAR; PG8_MMA(0, 0, At, B0); PG8_MMA(0, 1, At, B1); PG8_BAR; PG8_SCHED;
            PG8_LDA(At, 1, 1); PG8_STAGE(PG8_SB(1, 0), b3, voffB); PG8_STAGE(PG8_SB(1, 1), b3 + hstep, voffB); PG8_STAGE(PG8_SA(1, 0), a3, voffA);
            PG8_WAIT_V(8); PG8_WAIT_L(0); PG8_BAR; PG8_MMA(1, 0, At, B0); PG8_MMA(1, 1, At, B1); PG8_BAR; PG8_SCHED;
            } else {
            PG8_LDB(B0, 0, 0); PG8_SCHED; PG8_LDA(At, 0, 0); PG8_STAGE(PG8_SA(1, 1), a1 + hstep, voffA);
            PG8_WAIT_L(8); PG8_BAR; PG8_WAIT_L(0); PG8_MMA(0, 0, At, B0); PG8_BAR; PG8_SCHED;
            PG8_LDB(B1, 0, 1); PG8_STAGE(PG8_SB(0, 0), b2, voffB);
            PG8_BAR; PG8_WAIT_L(0); PG8_MMA(0, 1, At, B1); PG8_BAR;
            PG8_LDA(At, 0, 1); PG8_STAGE(PG8_SA(0, 0), a2, voffA);
            PG8_BAR; PG8_WAIT_L(0); PG8_MMA(1, 0, At, B0); PG8_BAR; PG8_SCHED;
            PG8_STAGE(PG8_SB(0, 1), b2 + hstep, voffB);
            PG8_WAIT_V(6); PG8_BAR; PG8_MMA(1, 1, At, B1); PG8_BAR;
            PG8_LDB(B0, 1, 0); PG8_SCHED; PG8_LDA(At, 1, 0); PG8_STAGE(PG8_SA(0, 1), a2 + hstep, voffA);
            PG8_WAIT_L(8); PG8_BAR; PG8_WAIT_L(0); PG8_MMA(0, 0, At, B0); PG8_BAR; PG8_SCHED;
            PG8_LDB(B1, 1, 1); PG8_STAGE(PG8_SB(1, 0), b3, voffB);
            PG8_BAR; PG8_WAIT_L(0); PG8_MMA(0, 1, At, B1); PG8_BAR;
            PG8_LDA(At, 1, 1); PG8_STAGE(PG8_SA(1, 0), a3, voffA);
            PG8_BAR; PG8_WAIT_L(0); PG8_MMA(1, 0, At, B0); PG8_BAR; PG8_SCHED;
            PG8_STAGE(PG8_SB(1, 1), b3 + hstep, voffB);
            PG8_WAIT_V(6); PG8_BAR; PG8_MMA(1, 1, At, B1); PG8_BAR;
            }
        }
        if constexpr (ALIGN_EPI) { if (wr == 0) PG8_BAR; }
        E(acc, cur, wr, wc, fr, fq);
        if (!has_next) break;
#pragma unroll
        for (int a = 0; a < 2; ++a)
#pragma unroll
            for (int b = 0; b < 2; ++b)
#pragma unroll
                for (int m = 0; m < 4; ++m)
#pragma unroll
                    for (int n = 0; n < 2; ++n) acc[a][b][m][n] = (f32x4){0.f, 0.f, 0.f, 0.f};
        cur = nxt; cA = nA; cB = nB; ++ui;
        if constexpr (ALIGN_EPI) { if (wr == 1) PG8_BAR; }
    }
    PG8_WAIT_V(0);
    if constexpr (!ALIGN_EPI) { if (wr == 0) PG8_BAR; }
    PG8_BAR;
#undef PG8_SA
#undef PG8_SB
#undef PG8_STAGE
#undef PG8_LDA
#undef PG8_LDB
#undef PG8_MMA
#undef PG8_WAIT_V
#undef PG8_WAIT_L
#undef PG8_BAR
#undef PG8_SCHED
}

struct EpiP {
    static constexpr bool PERM = true;
    bf16_t* O;
    __device__ __forceinline__ void operator()(const f32x4 (&acc)[2][2][4][2], const Unit& u, int wr, int wc, int fr, int fq) const {
        const int row0 = u.pm * BM + wr * 64 + fr, col0 = u.pn * BM + wc * 32 + 8 * fq;
#pragma unroll
        for (int ai = 0; ai < 2; ++ai)
#pragma unroll
            for (int m = 0; m < 4; ++m) { bf16_t* rowp = O + (size_t)(row0 + ai * HALF + m * 16) * N1 + col0;
#pragma unroll
                for (int bj = 0; bj < 2; ++bj) { const f32x4 v0 = acc[ai][bj][m][0], v1 = acc[ai][bj][m][1];
                    u32x4 w; w.x = cvt_pk_bf16(v0[0], v0[1]); w.y = cvt_pk_bf16(v0[2], v0[3]); w.z = cvt_pk_bf16(v1[0], v1[1]); w.w = cvt_pk_bf16(v1[2], v1[3]);
                    __builtin_nontemporal_store(w, (u32x4*)(rowp + bj * HALF)); } }
    }
};
struct EpiGate {
    static constexpr bool PERM = true;
    const bf16_t* P; float* YT; bf16_t* MRG; unsigned* flags;
    __device__ __forceinline__ void operator()(const f32x4 (&acc)[2][2][4][2], const Unit& u, int wr, int wc, int fr, int fq) const {
        const int row0 = u.pm * BM + wr * 64 + fr, col0 = u.pn * BM + wc * 32 + 8 * fq;
        const bool isb = (u.w & 1) != 0, remote = u.w >= 2;
        const int gcol = (isb ? C_MB : C_MA) + col0;
        unsigned* flag = flags + (size_t)((u.t * 8 + wr * 4 + wc) * 16);
        if (remote && isb) {
            unsigned spins = 0;
            while ((unsigned)__builtin_amdgcn_readfirstlane(__hip_atomic_load(flag, __ATOMIC_RELAXED, __HIP_MEMORY_SCOPE_AGENT)) == 0u) { __builtin_amdgcn_s_sleep(1); if (++spins > (1u << 16)) break; }
            __builtin_amdgcn_fence(__ATOMIC_ACQUIRE, "agent");
        }
#pragma unroll
        for (int ai = 0; ai < 2; ++ai)
#pragma unroll
            for (int m = 0; m < 4; ++m) { const size_t row = (size_t)(row0 + ai * HALF + m * 16);
#pragma unroll
                for (int bj = 0; bj < 2; ++bj) {
                    const u32x4 gw = *(const u32x4*)(P + row * N1 + gcol + bj * HALF);
                    f32x4 g0, g1;
                    g0[0] = sigmoidf_(bf_lo(gw.x)); g0[1] = sigmoidf_(bf_hi(gw.x)); g0[2] = sigmoidf_(bf_lo(gw.y)); g0[3] = sigmoidf_(bf_hi(gw.y));
                    g1[0] = sigmoidf_(bf_lo(gw.z)); g1[1] = sigmoidf_(bf_hi(gw.z)); g1[2] = sigmoidf_(bf_lo(gw.w)); g1[3] = sigmoidf_(bf_hi(gw.w));
                    f32x4 v0 = acc[ai][bj][m][0] * g0, v1 = acc[ai][bj][m][1] * g1;
                    float* yp = YT + row * D + col0 + bj * HALF;
                    if (!isb) {
                        if (!remote) { *(f32x4*)yp = v0; *(f32x4*)(yp + 4) = v1; }
                        else { unsigned long long* y8 = (unsigned long long*)yp;
                            __hip_atomic_store(y8 + 0, (unsigned long long)__float_as_uint(v0[0]) | ((unsigned long long)__float_as_uint(v0[1]) << 32), __ATOMIC_RELAXED, __HIP_MEMORY_SCOPE_AGENT);
                            __hip_atomic_store(y8 + 1, (unsigned long long)__float_as_uint(v0[2]) | ((unsigned long long)__float_as_uint(v0[3]) << 32), __ATOMIC_RELAXED, __HIP_MEMORY_SCOPE_AGENT);
                            __hip_atomic_store(y8 + 2, (unsigned long long)__float_as_uint(v1[0]) | ((unsigned long long)__float_as_uint(v1[1]) << 32), __ATOMIC_RELAXED, __HIP_MEMORY_SCOPE_AGENT);
                            __hip_atomic_store(y8 + 3, (unsigned long long)__float_as_uint(v1[2]) | ((unsigned long long)__float_as_uint(v1[3]) << 32), __ATOMIC_RELAXED, __HIP_MEMORY_SCOPE_AGENT); }
                    } else {
                        if (!remote) { v0 += *(const f32x4*)yp; v1 += *(const f32x4*)(yp + 4); }
                        else { unsigned long long* y8 = (unsigned long long*)yp;
                            const unsigned long long a0 = __hip_atomic_load(y8 + 0, __ATOMIC_RELAXED, __HIP_MEMORY_SCOPE_AGENT), a1 = __hip_atomic_load(y8 + 1, __ATOMIC_RELAXED, __HIP_MEMORY_SCOPE_AGENT),
                                                     a2 = __hip_atomic_load(y8 + 2, __ATOMIC_RELAXED, __HIP_MEMORY_SCOPE_AGENT), a3 = __hip_atomic_load(y8 + 3, __ATOMIC_RELAXED, __HIP_MEMORY_SCOPE_AGENT);
                            v0 += (f32x4){__uint_as_float((unsigned)a0), __uint_as_float((unsigned)(a0 >> 32)), __uint_as_float((unsigned)a1), __uint_as_float((unsigned)(a1 >> 32))};
                            v1 += (f32x4){__uint_as_float((unsigned)a2), __uint_as_float((unsigned)(a2 >> 32)), __uint_as_float((unsigned)a3), __uint_as_float((unsigned)(a3 >> 32))}; }
                        u32x4 w; w.x = cvt_pk_bf16(v0[0], v0[1]); w.y = cvt_pk_bf16(v0[2], v0[3]); w.z = cvt_pk_bf16(v1[0], v1[1]); w.w = cvt_pk_bf16(v1[2], v1[3]);
                        *(u32x4*)(MRG + row * D + col0 + bj * HALF) = w; } } }
        if (remote && !isb) {
            asm volatile("s_waitcnt vmcnt(0)" ::: "memory");
            if (fr == 0 && fq == 0) __hip_atomic_store(flag, 1u, __ATOMIC_RELAXED, __HIP_MEMORY_SCOPE_AGENT);
        }
    }
};
struct EpiOut {
    static constexpr bool PERM = false;
    const float *xp, *xs; float* O;
    __device__ __forceinline__ void operator()(const f32x4 (&acc)[2][2][4][2], const Unit& u, int wr, int wc, int fr, int fq) const {
        const int row0 = u.pm * BM + wr * 64 + fr, col0 = u.pn * BM + wc * 32 + 4 * fq;
#pragma unroll
        for (int ai = 0; ai < 2; ++ai)
#pragma unroll
            for (int m = 0; m < 4; ++m) { const int row = row0 + ai * HALF + m * 16;
                const float* xr = (row < NTP ? xp + (size_t)row * D : xs + (size_t)(row - NTP) * D) + col0; float* rowp = O + (size_t)row * D + col0;
#pragma unroll
                for (int bj = 0; bj < 2; ++bj)
#pragma unroll
                    for (int n = 0; n < 2; ++n) *(f32x4*)(rowp + bj * HALF + n * 16) = acc[ai][bj][m][n] + *(const f32x4*)(xr + bj * HALF + n * 16); }
    }
};
}

__device__ __forceinline__ int srccol(int n) {
    if (n < 4096) return n;
    if (n < 12288) return n + 16;
    if (n < 18432) return n + 48;
    if (n < 18448) return 4096 + (n - 18432);
    if (n < 18464) return 12304 + (n - 18448);
    if (n < 18480) return 12320 + (n - 18464);
    return -1;
}
__device__ __forceinline__ void phase0(const Params& p, LAS unsigned char* lds) {
    const int tid_ = otid(), lane = tid_ & 63, wave = tid_ >> 6;
    const int gw = blockIdx.x * 8 + wave, NGW = gridDim.x * 8;
    LAS float* scr = (LAS float*)(lds + wave * 16384);
    bf16_t* W1T = (bf16_t*)(p.ws + WS_W1T); bf16_t* WAT = (bf16_t*)(p.ws + WS_WAT); bf16_t* WBT = (bf16_t*)(p.ws + WS_WBT); bf16_t* WOT = (bf16_t*)(p.ws + WS_WOT);
    constexpr int I1 = 32 * (N1 / 32), I2 = 32 * 64, NI = I1 + 3 * I2;
    struct TI { const float* W; bf16_t* WT; int ldw, k0, n0, sc; };
    const float* w_a = p.w_br_a; const float* w_b = p.w_br_b; const float* w_o = p.w_out; const float* w_i = p.w_in;
    asm volatile("" : "+s"(w_a), "+s"(w_b), "+s"(w_o), "+s"(w_i));
    auto decode = [&](int it, TI& t) __attribute__((always_inline)) {
        int r = it; bool map = false;
        if (r < I1) { t.W = w_i; t.WT = W1T; t.ldw = DIN; t.k0 = 64 * (r / (N1 / 32)); t.n0 = 32 * (r % (N1 / 32)); map = true; }
        else { r -= I1; const int m = r / I2; r -= m * I2; t.W = (const float*)((uintptr_t)w_a + (m == 1 ? (uintptr_t)w_b - (uintptr_t)w_a : (uintptr_t)0) + (m == 2 ? (uintptr_t)w_o - (uintptr_t)w_a : (uintptr_t)0)); t.WT = WAT + (size_t)m * D * D;   t.ldw = D; t.k0 = 64 * (r / 64); t.n0 = 32 * (r % 64); }
        const int c = t.n0 + (lane & 31); t.sc = map ? srccol(c) : c;
    };
    if (gw < NI) {
        struct V8 { f32x4 a, b, c, d, e, f, g, h; };
        TI ta, tb; V8 va, vb;
        auto ld1 = [&](const TI& t, int i) __attribute__((always_inline)) -> float { const int kk = 2 * i + (lane >> 5); return t.sc >= 0 ? __builtin_nontemporal_load(t.W + (size_t)(t.k0 + kk) * t.ldw + t.sc) : 0.f; };
        auto ld4 = [&](const TI& t, int i) __attribute__((always_inline)) -> f32x4 { return (f32x4){ld1(t, 4 * i), ld1(t, 4 * i + 1), ld1(t, 4 * i + 2), ld1(t, 4 * i + 3)}; };
        auto issue = [&](const TI& t, V8& v) __attribute__((always_inline)) { v.a = ld4(t, 0); v.b = ld4(t, 1); v.c = ld4(t, 2); v.d = ld4(t, 3); v.e = ld4(t, 4); v.f = ld4(t, 5); v.g = ld4(t, 6); v.h = ld4(t, 7); };
        auto st4 = [&](f32x4 x, int i) __attribute__((always_inline)) {
#pragma unroll
            for (int e = 0; e < 4; ++e) scr[(2 * (4 * i + e) + (lane >> 5)) * 33 + (lane & 31)] = x[e]; };
        auto proc = [&](const TI& t, const V8& v) __attribute__((always_inline)) {
            st4(v.a, 0); st4(v.b, 1); st4(v.c, 2); st4(v.d, 3); st4(v.e, 4); st4(v.f, 5); st4(v.g, 6); st4(v.h, 7);
            LDS_WAIT(); const int c = lane & 7;
#pragma unroll
            for (int j = 0; j < 4; ++j) { const int n = (lane >> 3) + 8 * j; const LAS float* sp = scr + (8 * c) * 33 + n;
                u32x4 o; o.x = cvt_pk_bf16(sp[0 * 33], sp[1 * 33]); o.y = cvt_pk_bf16(sp[2 * 33], sp[3 * 33]); o.z = cvt_pk_bf16(sp[4 * 33], sp[5 * 33]); o.w = cvt_pk_bf16(sp[6 * 33], sp[7 * 33]);
                *(u32x4*)(t.WT + (size_t)(t.n0 + n) * D + t.k0 + 8 * c) = o; }
            LDS_WAIT();
        };
        decode(gw, ta); issue(ta, va);
        for (int it = gw; it < NI; it += 2 * NGW) {
            { const int n1 = it + NGW < NI ? it + NGW : it; decode(n1, tb); issue(tb, vb); }
            proc(ta, va);
            { const int n2 = it + 2 * NGW < NI ? it + 2 * NGW : it; decode(n2, ta); issue(ta, va); }
            if (it + NGW < NI) proc(tb, vb);
        }
    }
    bf16_t* H = (bf16_t*)(p.ws + WS_H);
    for (int row = gw; row < NT; row += NGW) {
        const float* xr = row < NTP ? p.x_prompt + (size_t)row * D : p.x_sample + (size_t)(row - NTP) * D;
        f32x4 v[8]; float ss = 0.f;
#pragma unroll
        for (int j = 0; j < 8; ++j) { v[j] = *(const f32x4*)(xr + j * 256 + lane * 4); ss += (v[j][0] * v[j][0] + v[j][1] * v[j][1]) + (v[j][2] * v[j][2] + v[j][3] * v[j][3]); }
        const float inv = rsqrtf(wave_sum_fast(ss) * (1.0f / D) + EPS);
#pragma unroll
        for (int j = 0; j < 8; ++j) { const f32x4 g = *(const f32x4*)(p.ln_in_g + j * 256 + lane * 4);
            u32x2 o; o.x = cvt_pk_bf16(v[j][0] * inv * g[0], v[j][1] * inv * g[1]); o.y = cvt_pk_bf16(v[j][2] * inv * g[2], v[j][3] * inv * g[3]);
            *(u32x2*)(H + (size_t)row * D + j * 256 + lane * 4) = o; }
    }
}

__device__ __forceinline__ u32 bf16_1(float x) { return cvt_pk_bf16(x, 0.f) & 0xffffu; }
__device__ __forceinline__ void gla_prep_item(const Params& p, LAS unsigned char* lds, int bh, int c) {
    const int tid = otid(), dk = tid & 255, half = tid >> 8, w = tid >> 6, lane = tid & 63, fr = lane & 15, fq = lane >> 4;
    const int b = bh >> 2, h = bh & 3, row0 = b * SEQ + c * 64, item = bh * 32 + c;
    LAS bf16_t* qd_s = (LAS bf16_t*)lds; LAS bf16_t* kd_s = qd_s + 64 * 264; LAS float* lr_s = (LAS float*)(kd_s + 64 * 264); LAS float* hs_s = lr_s + 1024;
    const bf16_t* P = (const bf16_t*)(p.ws + WS_P);
    bf16_t* QD = (bf16_t*)(p.ws + WS_QD) + (size_t)item * 16384; bf16_t* KET = (bf16_t*)(p.ws + WS_KET) + (size_t)item * 16384;
    bf16_t* ATT = (bf16_t*)(p.ws + WS_ATT) + (size_t)item * 4096; float* Eg = (float*)(p.ws + WS_E) + (size_t)item * 256;
    for (int e = tid; e < 1024; e += 512) lr_s[e] = bf1(P[(size_t)(row0 + (e >> 4)) * N1 + C_LR + (e & 15)]);
    u32x4 rq[4], rk[4];
#pragma unroll
    for (int i = 0; i < 4; ++i) { const int e = tid + 512 * i; rq[i] = *(const u32x4*)(P + (size_t)(row0 + (e >> 5)) * N1 + C_QA + h * 256 + (e & 31) * 8); rk[i] = *(const u32x4*)(P + (size_t)(row0 + (e >> 5)) * N1 + C_KA + h * 256 + (e & 31) * 8); }
    float w2r[16];
#pragma unroll
    for (int r = 0; r < 16; ++r) w2r[r] = p.w_alpha2[r * 1024 + h * 256 + dk];
    const float bias = p.b_alpha[h * 256 + dk];
    __syncthreads();
    float la[32]; float hsum = 0.f;
#pragma unroll
    for (int i = 0; i < 32; ++i) { const int t = half * 32 + i; float x = 0.f;
#pragma unroll
        for (int r4 = 0; r4 < 4; ++r4) { const f32x4 l4 = *(const LAS f32x4*)(lr_s + t * 16 + r4 * 4); x += l4[0] * w2r[r4 * 4] + l4[1] * w2r[r4 * 4 + 1] + l4[2] * w2r[r4 * 4 + 2] + l4[3] * w2r[r4 * 4 + 3]; }
        x += bias;
        la[i] = (fminf(x, 0.f) - __logf(1.0f + __expf(-fabsf(x)))) * (1.0f / 16.0f); hsum += la[i]; }
    hs_s[half * 256 + dk] = hsum;
#pragma unroll
    for (int i = 0; i < 4; ++i) { const int e = tid + 512 * i; *(LAS u32x4*)(qd_s + (e >> 5) * 264 + (e & 31) * 8) = rq[i]; *(LAS u32x4*)(kd_s + (e >> 5) * 264 + (e & 31) * 8) = rk[i]; }
    __syncthreads();
    const float h0 = hs_s[dk], h1 = hs_s[256 + dk], blast = h0 + h1;
    float bcur = half ? h0 : 0.f;
    if (half == 0) Eg[dk] = __expf(blast);
    u32 kep[16];
#pragma unroll
    for (int i = 0; i < 32; ++i) { const int t = half * 32 + i; bcur += la[i];
        const float q = bf1(qd_s[t * 264 + dk]), k = bf1(kd_s[t * 264 + dk]);
        const u32 qd = bf16_1(q * __expf(bcur)), kd = bf16_1(k * __expf(-bcur));
        const float ke = k * __expf(blast - bcur);
        qd_s[t * 264 + dk] = (bf16_t)qd; kd_s[t * 264 + dk] = (bf16_t)kd;
        if (i & 1) kep[i >> 1] |= bf16_1(ke) << 16; else kep[i >> 1] = bf16_1(ke); }
#pragma unroll
    for (int i = 0; i < 4; ++i) *(u32x4*)(KET + dk * 64 + half * 32 + i * 8) = (u32x4){kep[4 * i], kep[4 * i + 1], kep[4 * i + 2], kep[4 * i + 3]};
    __syncthreads();
#pragma unroll
    for (int i = 0; i < 4; ++i) { const int e = tid + 512 * i; *(u32x4*)(QD + (e >> 5) * 256 + (e & 31) * 8) = *(const LAS u32x4*)(qd_s + (e >> 5) * 264 + (e & 31) * 8); }
    { const int ib = w >> 1;
      f32x4 acc[2]; acc[0] = (f32x4){0.f, 0.f, 0.f, 0.f}; acc[1] = acc[0];
#pragma unroll
      for (int kk = 0; kk < 8; ++kk) {
          const bf16x8 bq = *(const LAS bf16x8*)(qd_s + (16 * ib + fr) * 264 + kk * 32 + 8 * fq);
#pragma unroll
          for (int n = 0; n < 2; ++n) { const int jb = 2 * (w & 1) + n;
              const bf16x8 ak = *(const LAS bf16x8*)(kd_s + (16 * jb + fr) * 264 + kk * 32 + 8 * fq);
              acc[n] = __builtin_amdgcn_mfma_f32_16x16x32_bf16(ak, bq, acc[n], 0, 0, 0); } }
#pragma unroll
      for (int n = 0; n < 2; ++n) { const int jb = 2 * (w & 1) + n, i = 16 * ib + fr, j0 = 16 * jb + 4 * fq;
          float v0 = (j0 + 0 <= i) ? acc[n][0] : 0.f, v1 = (j0 + 1 <= i) ? acc[n][1] : 0.f, v2 = (j0 + 2 <= i) ? acc[n][2] : 0.f, v3 = (j0 + 3 <= i) ? acc[n][3] : 0.f;
          *(u32x2*)(ATT + i * 64 + j0) = (u32x2){cvt_pk_bf16(v0, v1), cvt_pk_bf16(v2, v3)}; } }
    __syncthreads();
}

__device__ __forceinline__ void phase2(const Params& p, LAS unsigned char* lds) {
    const int tid_ = otid(), lane = tid_ & 63, wave = tid_ >> 6;
    const int gw = blockIdx.x * 8 + wave, NGW = gridDim.x * 8;
    const bf16_t* P = (const bf16_t*)(p.ws + WS_P);
    float* QB = (float*)(p.ws + WS_QB); float* KB = (float*)(p.ws + WS_KB); float* VB = (float*)(p.ws + WS_VB);
    for (int it = gw; it < (NT / 8) * 12; it += NGW) {
        const int R = it / 12, quad = it % 12, tok0 = R * 8;
        int t0, sb; if (tok0 < NTP) { t0 = tok0 & (SEQ - 1); sb = -1; } else { t0 = 0; sb = (tok0 - NTP) >> 3; }
        f32x2 x[11][4], cw[4][4];
#pragma unroll
        for (int u = 0; u < 4; ++u) { const int c = (quad * 4 + u) * 128 + lane * 2;
#pragma unroll
            for (int i = 0; i < 4; ++i) cw[i][u] = *(const f32x2*)(p.conv_w + (size_t)i * 6144 + c);
#pragma unroll
            for (int j = 0; j < 11; ++j) {
                const int t = t0 - 3 + j;
                if (j >= 3 || t >= 0) { const u32 w = *(const u32*)(P + (size_t)(tok0 - 3 + j) * N1 + C_QKVB + c); x[j][u] = (f32x2){bf_lo(w), bf_hi(w)}; }
                else if (sb >= 0) x[j][u] = *(const f32x2*)(p.state_conv + ((size_t)sb * 3 + j) * 6144 + c);
                else x[j][u] = (f32x2){0.f, 0.f};
            } }
#pragma unroll
        for (int tt = 0; tt < 8; ++tt) {
            f32x2 y[4];
#pragma unroll
            for (int u = 0; u < 4; ++u) { f32x2 a = x[tt][u] * cw[0][u]; a += x[tt + 1][u] * cw[1][u]; a += x[tt + 2][u] * cw[2][u]; a += x[tt + 3][u] * cw[3][u];
                y[u] = (f32x2){siluf_(a[0]), siluf_(a[1])}; }
            const size_t tok = (size_t)(tok0 + tt);
            if (quad < 8) {
#pragma unroll
                for (int u = 0; u < 4; ++u) {
                    float sc = rsqrtf(wave_sum_fast(y[u][0] * y[u][0] + y[u][1] * y[u][1]) + EPS); if (quad < 4) sc *= 0.08838834764831845f;
                    float* dst = (quad < 4 ? QB : KB) + tok * D + ((quad & 3) * 4 + u) * 128 + lane * 2;
                    *(f32x2*)dst = y[u] * sc; }
            } else {
#pragma unroll
                for (int u = 0; u < 4; ++u) *(f32x2*)(VB + tok * D + ((quad - 8) * 4 + u) * 128 + lane * 2) = y[u];
            }
        }
    }
    float* ALPHA = (float*)(p.ws + WS_ALPHA);
    for (int it = gw; it < NTS * 4; it += NGW) {
        const int tok = NTP + (it >> 2), j = (it & 3) * 256 + lane * 4;
        f32x4 acc = (f32x4){0.f, 0.f, 0.f, 0.f};
#pragma unroll
        for (int r = 0; r < 16; ++r) { const float lr = bf1(P[(size_t)tok * N1 + C_LR + r]); acc += lr * *(const f32x4*)(p.w_alpha2 + r * 1024 + j); }
        acc += *(const f32x4*)(p.b_alpha + j);
        f32x4 o;
#pragma unroll
        for (int e = 0; e < 4; ++e) { const float x = acc[e]; const float ls = fminf(x, 0.f) - log1pf(expf(-fabsf(x))); o[e] = expf(ls * (1.0f / 16.0f)); }
        *(f32x4*)(ALPHA + (size_t)tok * 1024 + j) = o;
    }
    float* BETA = (float*)(p.ws + WS_BETA); float* GA = (float*)(p.ws + WS_GA);
    for (int it = gw; it < NT / 4; it += NGW) {
        const int tok = it * 4 + (lane >> 4), h = lane & 15;
        const float bb = bf1(P[(size_t)tok * N1 + C_BETA + h]), dd = bf1(P[(size_t)tok * N1 + C_DEC + h]);
        BETA[tok * 16 + h] = 1.0f / (1.0f + expf(-bb));
        const float g = -expf(p.a_log[h]) * softplusf_(dd + p.dt_bias[h]);
        GA[tok * 16 + h] = expf(g); ((float*)(p.ws + WS_GL))[tok * 16 + h] = g;
    }
    const int gt = blockIdx.x * 512 + tid_, NG = gridDim.x * 512;
    for (int i = gt; i < (4 + 128) * 3 * 768; i += NG) {
        const int seq = i / (3 * 768), r = (i / 768) % 3, c8 = (i % 768) * 8;
        const size_t row = seq < 4 ? (size_t)(seq * SEQ + SEQ - 3 + r) : (size_t)(NTP + (seq - 4) * DSEQ + DSEQ - 3 + r);
        float* dst = seq < 4 ? p.out + O_CONV_P + ((size_t)seq * 3 + r) * 6144 + c8 : p.out + O_CONV_S + ((size_t)(seq - 4) * 3 + r) * 6144 + c8;
        const u32x4 w = *(const u32x4*)(P + row * N1 + C_QKVB + c8);
        *(f32x4*)dst = (f32x4){bf_lo(w.x), bf_hi(w.x), bf_lo(w.y), bf_hi(w.y)}; *(f32x4*)(dst + 4) = (f32x4){bf_lo(w.z), bf_hi(w.z), bf_lo(w.w), bf_hi(w.w)};
    }
    for (int it = blockIdx.x; it < 512; it += gridDim.x) gla_prep_item(p, lds, it >> 5, it & 31);
}

__device__ __forceinline__ void gla_sample_item(const Params& p, LAS unsigned char* lds, int b, int h) {
    const int tid = otid(), w = tid >> 6, lane = tid & 63, dkl = lane >> 3, dvl = lane & 7, dkb = w * 32 + dkl * 4;
    LAS float* qs = (LAS float*)lds; LAS float* ks = qs + 2048; LAS float* as = ks + 2048; LAS float* vs = as + 2048; LAS float* part = vs + 4096;
    const bf16_t* P = (const bf16_t*)(p.ws + WS_P); const float* ALPHA = (const float*)(p.ws + WS_ALPHA); float* OA = (float*)(p.ws + WS_OA);
    const int row0 = NTP + b * DSEQ;
    const float* st_in = p.state_gla + (size_t)(b * 4 + h) * 131072; float* st_out = p.out + O_GLA_S + (size_t)(b * 4 + h) * 131072;
    f32x4 Sn[4];
#pragma unroll
    for (int i = 0; i < 4; ++i) Sn[i] = __builtin_nontemporal_load((const f32x4*)(st_in + (size_t)(dkb + i) * 512 + dvl * 4));
    { const int tt = tid >> 6, pc = tid & 63; const size_t row = (size_t)(row0 + tt);
      const u32x2 rq = *(const u32x2*)(P + row * N1 + C_QA + h * 256 + pc * 4), rk = *(const u32x2*)(P + row * N1 + C_KA + h * 256 + pc * 4);
      const f32x4 ra = *(const f32x4*)(ALPHA + row * 1024 + h * 256 + pc * 4);
      const u32x4 rv = *(const u32x4*)(P + row * N1 + C_VA + h * 512 + pc * 8);
      *(LAS f32x4*)(qs + tt * 256 + pc * 4) = (f32x4){bf_lo(rq.x), bf_hi(rq.x), bf_lo(rq.y), bf_hi(rq.y)};
      *(LAS f32x4*)(ks + tt * 256 + pc * 4) = (f32x4){bf_lo(rk.x), bf_hi(rk.x), bf_lo(rk.y), bf_hi(rk.y)};
      *(LAS f32x4*)(as + tt * 256 + pc * 4) = ra;
      *(LAS f32x4*)(vs + tt * 512 + pc * 8) = (f32x4){bf_lo(rv.x), bf_hi(rv.x), bf_lo(rv.y), bf_hi(rv.y)};
      *(LAS f32x4*)(vs + tt * 512 + pc * 8 + 4) = (f32x4){bf_lo(rv.z), bf_hi(rv.z), bf_lo(rv.w), bf_hi(rv.w)}; }
    __syncthreads();
    for (int s = 0; s < 16; ++s) {
        f32x4 S[4];
#pragma unroll
        for (int i = 0; i < 4; ++i) S[i] = Sn[i];
        { const int sn = (s + 1) & 15;
#pragma unroll
            for (int i = 0; i < 4; ++i) Sn[i] = __builtin_nontemporal_load((const f32x4*)(st_in + (size_t)(dkb + i) * 512 + sn * 32 + dvl * 4));
        }
        LAS float* pt = part + (s & 1) * 2048;
#pragma unroll 2
        for (int t = 0; t < 8; ++t) {
            const f32x4 q4 = *(const LAS f32x4*)(qs + t * 256 + dkb), k4 = *(const LAS f32x4*)(ks + t * 256 + dkb), a4 = *(const LAS f32x4*)(as + t * 256 + dkb);
            const f32x4 v4 = *(const LAS f32x4*)(vs + t * 512 + s * 32 + dvl * 4);
            f32x4 o = (f32x4){0.f, 0.f, 0.f, 0.f};
#pragma unroll
            for (int i = 0; i < 4; ++i) { S[i] = a4[i] * S[i] + k4[i] * v4; o += q4[i] * S[i]; }
#pragma unroll
            for (int j = 0; j < 4; ++j) (void)j;
            {
                const auto r01 = __builtin_amdgcn_permlane32_swap(__float_as_uint(o[0]), __float_as_uint(o[1]), false, false);
                const auto r23 = __builtin_amdgcn_permlane32_swap(__float_as_uint(o[2]), __float_as_uint(o[3]), false, false);
                const float s01 = __uint_as_float(r01[0]) + __uint_as_float(r01[1]), s23 = __uint_as_float(r23[0]) + __uint_as_float(r23[1]);
                const auto rr = __builtin_amdgcn_permlane16_swap(__float_as_uint(s01), __float_as_uint(s23), false, false);
                float x = __uint_as_float(rr[0]) + __uint_as_float(rr[1]);
                x += dpp<ROR8>(x);
                const int R = lane >> 4;
                if ((lane & 8) == 0) pt[(w * 8 + t) * 32 + dvl * 4 + (((R & 1) << 1) | (R >> 1))] = x; }
        }
#pragma unroll
        for (int i = 0; i < 4; ++i) __builtin_nontemporal_store(S[i], (f32x4*)(st_out + (size_t)(dkb + i) * 512 + s * 32 + dvl * 4));
        lds_barrier();
        if (tid < 256) { const int tt = tid >> 5, pc = tid & 31; float sum = 0.f;
#pragma unroll
            for (int ww = 0; ww < 8; ++ww) sum += pt[(ww * 8 + tt) * 32 + pc];
            OA[(size_t)(row0 + tt) * D + h * 512 + s * 32 + pc] = sum * 0.0625f; }
    }
    __syncthreads();
}
__device__ __forceinline__ void gdn_item(const Params& p, LAS unsigned char* lds, int row0, int T, int h, int s, const float* st_in, float* st_out) {
    const int tid = otid(), w = tid >> 6, lane = tid & 63, g = lane >> 2, j = lane & 3, dvl = w * 4 + j;
    LAS float* qs = (LAS float*)lds; LAS float* ks = qs + 2048; LAS float* vs = ks + 2048; LAS float* bs = vs + 512; LAS float* gs = bs + 16; LAS float* os = gs + 16; LAS float* sst = os + 512;
    const float* QB = (const float*)(p.ws + WS_QB); const float* KB = (const float*)(p.ws + WS_KB); const float* VB = (const float*)(p.ws + WS_VB);
    const float* BETA = (const float*)(p.ws + WS_BETA); const float* GA = (const float*)(p.ws + WS_GA); float* OB = (float*)(p.ws + WS_OB);
    float S[8];
    if (st_in) {
#pragma unroll
        for (int i = 0; i < 8; ++i) { const int e = tid + 512 * i; sst[(e >> 5) * 33 + (e & 31)] = st_in[(size_t)(e >> 5) * 128 + s * 32 + (e & 31)]; }
        __syncthreads();
#pragma unroll
        for (int i = 0; i < 8; ++i) S[i] = sst[(g * 8 + i) * 33 + dvl];
    } else {
#pragma unroll
        for (int i = 0; i < 8; ++i) S[i] = 0.f;
    }
    const int tt = tid >> 5, pc = tid & 31;
    f32x4 rq, rk; float rv, rb, ra;
    auto load_regs = [&](int t0) {
        const int t = t0 + tt;
        if (t < T) { const size_t row = (size_t)(row0 + t);
            rq = *(const f32x4*)(QB + row * D + h * 128 + pc * 4); rk = *(const f32x4*)(KB + row * D + h * 128 + pc * 4);
            rv = VB[row * D + h * 128 + s * 32 + pc];
            if (pc == 0) { rb = BETA[row * 16 + h]; ra = GA[row * 16 + h]; } }
        else { rq = (f32x4){0.f, 0.f, 0.f, 0.f}; rk = rq; rv = 0.f; rb = 0.f; ra = 1.f; }
    };
    load_regs(0);
    for (int t0 = 0; t0 < T; t0 += 16) {
        const int nt = (T - t0) < 16 ? (T - t0) : 16;
        *(LAS f32x4*)(qs + tt * 128 + pc * 4) = rq; *(LAS f32x4*)(ks + tt * 128 + pc * 4) = rk; vs[tt * 32 + pc] = rv;
        if (pc == 0) { bs[tt] = rb; gs[tt] = ra; }
        __syncthreads();
        if (t0 + 16 < T) load_regs(t0 + 16);
        for (int t = 0; t < nt; ++t) {
            const f32x4 k0 = *(const LAS f32x4*)(ks + t * 128 + g * 8), k1 = *(const LAS f32x4*)(ks + t * 128 + g * 8 + 4);
            const f32x4 q0 = *(const LAS f32x4*)(qs + t * 128 + g * 8), q1 = *(const LAS f32x4*)(qs + t * 128 + g * 8 + 4);
            const float v = vs[t * 32 + dvl], a = gs[t], b = bs[t];
            float kS = 0.f, qS = 0.f, qk = 0.f;
#pragma unroll
            for (int i = 0; i < 4; ++i) { kS += k0[i] * S[i]; qS += q0[i] * S[i]; qk += q0[i] * k0[i]; }
#pragma unroll
            for (int i = 0; i < 4; ++i) { kS += k1[i] * S[4 + i]; qS += q1[i] * S[4 + i]; qk += q1[i] * k1[i]; }
            kS += dpp<ROR4>(kS); qS += dpp<ROR4>(qS); qk += dpp<ROR4>(qk);
            kS += dpp<ROR8>(kS); qS += dpp<ROR8>(qS); qk += dpp<ROR8>(qk);
            kS = xrow16_sum(kS); qS = xrow16_sum(qS); qk = xrow16_sum(qk);
            const float u = v - a * kS, bu = b * u;
            const float o = a * qS + qk * bu;
#pragma unroll
            for (int i = 0; i < 4; ++i) { S[i] = a * S[i] + bu * k0[i]; S[4 + i] = a * S[4 + i] + bu * k1[i]; }
            if (lane < 4) os[t * 32 + dvl] = o;
        }
        __syncthreads();
        if (tt < nt) OB[(size_t)(row0 + t0 + tt) * D + h * 128 + s * 32 + pc] = os[tt * 32 + pc];
    }
#pragma unroll
    for (int i = 0; i < 8; ++i) sst[(g * 8 + i) * 33 + dvl] = S[i];
    __syncthreads();
#pragma unroll
    for (int i = 0; i < 8; ++i) { const int e = tid + 512 * i; st_out[(size_t)(e >> 5) * 128 + s * 32 + (e & 31)] = sst[(e >> 5) * 33 + (e & 31)]; }
    __syncthreads();
}
__device__ __forceinline__ void gdn_sample_item(const Params& p, LAS unsigned char* lds, int b, int h) {
    const int tid = otid(), w = tid >> 6, lane = tid & 63, g = lane >> 2, j = lane & 3, dvl = w * 4 + j;
    LAS float* qs = (LAS float*)lds; LAS float* ks = qs + 1024; LAS float* vs = ks + 1024; LAS float* bts = vs + 1024; LAS float* egs = bts + 8; LAS float* els = egs + 8; LAS float* ghs = els + 8;
    LAS float* Mm = ghs + 16; LAS float* QKm = Mm + 64; LAS float* os = QKm + 64; LAS float* red = os + 512; LAS float* sst = red + 512;
    const float* QB = (const float*)(p.ws + WS_QB); const float* KB = (const float*)(p.ws + WS_KB); const float* VB = (const float*)(p.ws + WS_VB);
    const float* BETA = (const float*)(p.ws + WS_BETA); const float* GL = (const float*)(p.ws + WS_GL); float* OB = (float*)(p.ws + WS_OB);
    const int row0 = NTP + b * DSEQ;
    const float* st_in = p.state_gdn + (size_t)(b * 16 + h) * 16384; float* st_out = p.out + O_GDN_S + (size_t)(b * 16 + h) * 16384;
    float pre[8];
#pragma unroll
    for (int i = 0; i < 8; ++i) { const int e = tid + 512 * i; pre[i] = __builtin_nontemporal_load(st_in + (size_t)(e >> 5) * 128 + (e & 31)); }
    if (tid < 256) { const int tt = tid >> 5, pc = tid & 31; const size_t row = (size_t)(row0 + tt);
        *(LAS f32x4*)(qs + tt * 128 + pc * 4) = *(const f32x4*)(QB + row * D + h * 128 + pc * 4);
        *(LAS f32x4*)(ks + tt * 128 + pc * 4) = *(const f32x4*)(KB + row * D + h * 128 + pc * 4);
        *(LAS f32x4*)(vs + tt * 128 + pc * 4) = *(const f32x4*)(VB + row * D + h * 128 + pc * 4); }
    if (w == 4) {
        const int t = lane & 7; float gv = GL[(size_t)(row0 + t) * 16 + h];
#pragma unroll
        for (int o = 1; o < 8; o <<= 1) { const float y = __shfl_up(gv, o); if (t >= o) gv += y; }
        const float gh7 = __shfl(gv, 7);
        if (lane < 8) { ghs[t] = gv; egs[t] = expf(gv); bts[t] = BETA[(size_t)(row0 + t) * 16 + h]; els[t] = expf(gh7 - gv); if (t == 7) ghs[8] = expf(gv); } }
#pragma unroll
    for (int i = 0; i < 8; ++i) { const int e = tid + 512 * i; sst[(e >> 5) * 33 + (e & 31)] = pre[i]; }
    __syncthreads();
    {
        const int t = tid >> 6, jj = (tid >> 3) & 7, part = tid & 7; float kk = 0.f, qk = 0.f;
#pragma unroll
        for (int i = 0; i < 4; ++i) { const f32x4 kt = *(const LAS f32x4*)(ks + t * 128 + part * 16 + 4 * i), kj = *(const LAS f32x4*)(ks + jj * 128 + part * 16 + 4 * i), qt = *(const LAS f32x4*)(qs + t * 128 + part * 16 + 4 * i);
            kk += kt[0] * kj[0] + kt[1] * kj[1] + kt[2] * kj[2] + kt[3] * kj[3]; qk += qt[0] * kj[0] + qt[1] * kj[1] + qt[2] * kj[2] + qt[3] * kj[3]; }
        kk += dpp<0xB1>(kk); qk += dpp<0xB1>(qk); kk += dpp<0x4E>(kk); qk += dpp<0x4E>(qk); kk += dpp<0x141>(kk); qk += dpp<0x141>(qk);
        if (part == 0) { const float dec = expf(ghs[t] - ghs[jj]); Mm[t * 8 + jj] = jj < t ? bts[t] * kk * dec : 0.f; QKm[t * 8 + jj] = jj <= t ? qk * dec : 0.f; }
    }
    __syncthreads();
    const int b5 = lane >> 5, b4 = (lane >> 4) & 1, b3 = (lane >> 3) & 1, b2 = (lane >> 2) & 1;
    const int ridx = 8 * b2 + 4 * b3 + 2 * b4 + b5;
    LAS float* myred = red + (w * 4 + j) * 16;
    for (int s = 0; s < 4; ++s) {
        LAS float* cur = sst + (s & 1) * 4224; LAS float* nxt = sst + ((s + 1) & 1) * 4224;
        float S[8];
#pragma unroll
        for (int i = 0; i < 8; ++i) S[i] = cur[(g * 8 + i) * 33 + dvl];
        { const int sn = (s + 1) & 3;
#pragma unroll
            for (int i = 0; i < 8; ++i) { const int e = tid + 512 * i; pre[i] = __builtin_nontemporal_load(st_in + (size_t)(e >> 5) * 128 + sn * 32 + (e & 31)); }
        }
        f32x4 kr0[8], kr1[8]; float v16[16];
#pragma unroll
        for (int t = 0; t < 8; ++t) {
            kr0[t] = *(const LAS f32x4*)(ks + t * 128 + g * 8); kr1[t] = *(const LAS f32x4*)(ks + t * 128 + g * 8 + 4);
            const f32x4 q0 = *(const LAS f32x4*)(qs + t * 128 + g * 8), q1 = *(const LAS f32x4*)(qs + t * 128 + g * 8 + 4);
            float a = 0.f, c = 0.f;
#pragma unroll
            for (int i = 0; i < 4; ++i) { a += kr0[t][i] * S[i]; c += q0[i] * S[i]; }
#pragma unroll
            for (int i = 0; i < 4; ++i) { a += kr1[t][i] * S[4 + i]; c += q1[i] * S[4 + i]; }
            v16[t] = a; v16[8 + t] = c; }
        float wA[8], xB[4], yC[2];
#pragma unroll
        for (int m = 0; m < 8; ++m) { const auto r = __builtin_amdgcn_permlane32_swap(__float_as_uint(v16[2 * m]), __float_as_uint(v16[2 * m + 1]), false, false); wA[m] = __uint_as_float(r[0]) + __uint_as_float(r[1]); }
#pragma unroll
        for (int n = 0; n < 4; ++n) { const auto r = __builtin_amdgcn_permlane16_swap(__float_as_uint(wA[2 * n]), __float_as_uint(wA[2 * n + 1]), false, false); xB[n] = __uint_as_float(r[0]) + __uint_as_float(r[1]); }
#pragma unroll
        for (int q = 0; q < 2; ++q) { const float send = b3 ? xB[2 * q] : xB[2 * q + 1], keep = b3 ? xB[2 * q + 1] : xB[2 * q]; yC[q] = keep + dpp<ROR8>(send); }
        float zD; { const float send = b2 ? yC[0] : yC[1], keep = b2 ? yC[1] : yC[0]; zD = keep + __shfl_xor(send, 4); }
        myred[ridx] = zD;
        LDS_WAIT();
        float r16[16];
#pragma unroll
        for (int i = 0; i < 4; ++i) { const f32x4 x = *(const LAS f32x4*)(myred + 4 * i); r16[4 * i] = x[0]; r16[4 * i + 1] = x[1]; r16[4 * i + 2] = x[2]; r16[4 * i + 3] = x[3]; }
        LDS_WAIT();
        LAS float* ot = os + (s & 1) * 256;
        float vn[8];
#pragma unroll
        for (int t = 0; t < 8; ++t) {
            float x = bts[t] * (vs[t * 128 + s * 32 + dvl] - egs[t] * r16[t]);
            float o = egs[t] * r16[8 + t];
#pragma unroll
            for (int jj = 0; jj < 8; ++jj) { if (jj < t) { x -= Mm[t * 8 + jj] * vn[jj]; o += QKm[t * 8 + jj] * vn[jj]; } }
            vn[t] = x; o += QKm[t * 8 + t] * x;
            if (lane < 4) ot[t * 32 + dvl] = o; }
        { const float e7 = ghs[8];
#pragma unroll
          for (int i = 0; i < 8; ++i) S[i] *= e7;
#pragma unroll
          for (int t = 0; t < 8; ++t) { const float c = els[t] * vn[t];
#pragma unroll
              for (int i = 0; i < 4; ++i) { S[i] += kr0[t][i] * c; S[4 + i] += kr1[t][i] * c; } } }
#pragma unroll
        for (int i = 0; i < 8; ++i) cur[(g * 8 + i) * 33 + dvl] = S[i];
        if (s + 1 < 4) {
#pragma unroll
            for (int i = 0; i < 8; ++i) { const int e = tid + 512 * i; nxt[(e >> 5) * 33 + (e & 31)] = pre[i]; }
        }
        lds_barrier();
#pragma unroll
        for (int i = 0; i < 8; ++i) { const int e = tid + 512 * i; __builtin_nontemporal_store(cur[(e >> 5) * 33 + (e & 31)], st_out + (size_t)(e >> 5) * 128 + s * 32 + (e & 31)); }
        if (tid < 256) OB[(size_t)(row0 + (tid >> 5)) * D + h * 128 + s * 32 + (tid & 31)] = ot[tid];
        lds_barrier();
    }
}
__device__ __forceinline__ void gdn_prep_item(const Params& p, LAS unsigned char* lds, int bh, int cg) {
    const int tid = otid(), w = tid >> 6, lane = tid & 63, fr = lane & 15, fq = lane >> 4;
    const int b = bh >> 4, h = bh & 15;
    LAS bf16_t* k_s = (LAS bf16_t*)lds; LAS bf16_t* q_s = k_s + 64 * 136; LAS bf16_t* klo_s = q_s + 64 * 136;
    LAS float* mp = (LAS float*)(lds + 53248);
    LAS float* gh_all = (LAS float*)(lds + 120832); LAS float* bt_all = gh_all + 512;
    const bf16_t* P = (const bf16_t*)(p.ws + WS_P);
    const float* QB = (const float*)(p.ws + WS_QB); const float* KB = (const float*)(p.ws + WS_KB); const float* VB = (const float*)(p.ws + WS_VB);
    const int item0 = bh * 32 + cg * 8, rowg = b * SEQ + cg * 512;
    { const size_t row = (size_t)(rowg + w * 64 + lane);
      const float bt = 1.0f / (1.0f + expf(-bf1(P[row * N1 + C_BETA + h])));
      float g = -expf(p.a_log[h]) * softplusf_(bf1(P[row * N1 + C_DEC + h]) + p.dt_bias[h]);
#pragma unroll
      for (int o = 1; o < 64; o <<= 1) { const float y = __shfl_up(g, o); if (lane >= o) g += y; }
      gh_all[w * 64 + lane] = g; bt_all[w * 64 + lane] = bt;
      if (lane == 63) ((float*)(p.ws + WS_GEG))[item0 + w] = expf(g); }
    const int t = tid >> 3, pc = tid & 7;
    f32x4 kvn[4], qvn[4];
#pragma unroll
    for (int i = 0; i < 4; ++i) { kvn[i] = *(const f32x4*)(KB + (size_t)(rowg + t) * D + h * 128 + pc * 16 + 4 * i); qvn[i] = *(const f32x4*)(QB + (size_t)(rowg + t) * D + h * 128 + pc * 16 + 4 * i); }
    __syncthreads();
    for (int cc = 0; cc < 8; ++cc) {
        const int item = item0 + cc;
        f32x4 qv[4];
        { u32 kh[8], kl[8], qh[8];
#pragma unroll
          for (int i = 0; i < 4; ++i) { const f32x4 kv = kvn[i]; qv[i] = qvn[i];
              kh[2 * i] = cvt_pk_bf16(kv[0], kv[1]); kh[2 * i + 1] = cvt_pk_bf16(kv[2], kv[3]);
              kl[2 * i] = cvt_pk_bf16(kv[0] - bf_lo(kh[2 * i]), kv[1] - bf_hi(kh[2 * i])); kl[2 * i + 1] = cvt_pk_bf16(kv[2] - bf_lo(kh[2 * i + 1]), kv[3] - bf_hi(kh[2 * i + 1]));
              qh[2 * i] = cvt_pk_bf16(qv[i][0], qv[i][1]); qh[2 * i + 1] = cvt_pk_bf16(qv[i][2], qv[i][3]); }
          *(LAS u32x4*)(k_s + t * 136 + pc * 16) = (u32x4){kh[0], kh[1], kh[2], kh[3]}; *(LAS u32x4*)(k_s + t * 136 + pc * 16 + 8) = (u32x4){kh[4], kh[5], kh[6], kh[7]};
          *(LAS u32x4*)(klo_s + t * 136 + pc * 16) = (u32x4){kl[0], kl[1], kl[2], kl[3]}; *(LAS u32x4*)(klo_s + t * 136 + pc * 16 + 8) = (u32x4){kl[4], kl[5], kl[6], kl[7]};
          *(LAS u32x4*)(q_s + t * 136 + pc * 16) = (u32x4){qh[0], qh[1], qh[2], qh[3]}; *(LAS u32x4*)(q_s + t * 136 + pc * 16 + 8) = (u32x4){qh[4], qh[5], qh[6], qh[7]}; }
        lds_barrier();
        { const int cn = cc + 1 < 8 ? cc + 1 : 7;
#pragma unroll
          for (int i = 0; i < 4; ++i) { kvn[i] = *(const f32x4*)(KB + (size_t)(rowg + cn * 64 + t) * D + h * 128 + pc * 16 + 4 * i); qvn[i] = *(const f32x4*)(QB + (size_t)(rowg + cn * 64 + t) * D + h * 128 + pc * 16 + 4 * i); } }
        const LAS float* gh = gh_all + cc * 64; const LAS float* bt = bt_all + cc * 64;
        {
          const float e = __expf(gh[t]); bf16_t* dst = (bf16_t*)(p.ws + WS_GQG) + (size_t)item * 8192 + t * 128 + pc * 16;
          *(u32x4*)dst = (u32x4){cvt_pk_bf16(qv[0][0] * e, qv[0][1] * e), cvt_pk_bf16(qv[0][2] * e, qv[0][3] * e), cvt_pk_bf16(qv[1][0] * e, qv[1][1] * e), cvt_pk_bf16(qv[1][2] * e, qv[1][3] * e)};
          *(u32x4*)(dst + 8) = (u32x4){cvt_pk_bf16(qv[2][0] * e, qv[2][1] * e), cvt_pk_bf16(qv[2][2] * e, qv[2][3] * e), cvt_pk_bf16(qv[3][0] * e, qv[3][1] * e), cvt_pk_bf16(qv[3][2] * e, qv[3][3] * e)}; }
        {
          const int dk = tid & 127, qt = tid >> 7; const float gl = gh[63]; u32 pk[8];
#pragma unroll
          for (int i = 0; i < 8; ++i) { const int t0 = qt * 16 + 2 * i;
              const float k0 = (bf1(k_s[t0 * 136 + dk]) + bf1(klo_s[t0 * 136 + dk])) * __expf(gl - gh[t0]), k1 = (bf1(k_s[(t0 + 1) * 136 + dk]) + bf1(klo_s[(t0 + 1) * 136 + dk])) * __expf(gl - gh[t0 + 1]);
              pk[i] = cvt_pk_bf16(k0, k1); }
          bf16_t* dst = (bf16_t*)(p.ws + WS_GKE) + (size_t)item * 8192 + dk * 64 + qt * 16;
          *(u32x4*)dst = (u32x4){pk[0], pk[1], pk[2], pk[3]}; *(u32x4*)(dst + 8) = (u32x4){pk[4], pk[5], pk[6], pk[7]}; }
        {
          const int ib = w >> 1;
          f32x4 am[2], aq[2]; am[0] = (f32x4){0.f, 0.f, 0.f, 0.f}; am[1] = am[0]; aq[0] = am[0]; aq[1] = am[0];
#pragma unroll
          for (int kk = 0; kk < 4; ++kk) {
              const bf16x8 ki = *(const LAS bf16x8*)(k_s + (16 * ib + fr) * 136 + kk * 32 + 8 * fq), qi = *(const LAS bf16x8*)(q_s + (16 * ib + fr) * 136 + kk * 32 + 8 * fq);
              const bf16x8 kil = *(const LAS bf16x8*)(klo_s + (16 * ib + fr) * 136 + kk * 32 + 8 * fq);
#pragma unroll
              for (int n = 0; n < 2; ++n) { const int jb = 2 * (w & 1) + n;
                  const bf16x8 kj = *(const LAS bf16x8*)(k_s + (16 * jb + fr) * 136 + kk * 32 + 8 * fq), kjl = *(const LAS bf16x8*)(klo_s + (16 * jb + fr) * 136 + kk * 32 + 8 * fq);
                  am[n] = __builtin_amdgcn_mfma_f32_16x16x32_bf16(ki, kj, am[n], 0, 0, 0);
                  am[n] = __builtin_amdgcn_mfma_f32_16x16x32_bf16(ki, kjl, am[n], 0, 0, 0);
                  am[n] = __builtin_amdgcn_mfma_f32_16x16x32_bf16(kil, kj, am[n], 0, 0, 0);
                  aq[n] = __builtin_amdgcn_mfma_f32_16x16x32_bf16(kj, qi, aq[n], 0, 0, 0); } }
          LAS float* mpc = mp + cc * 2048;
          bf16_t* QKM = (bf16_t*)(p.ws + WS_GQKM) + (size_t)item * 4096;
#pragma unroll
          for (int n = 0; n < 2; ++n) { const int jb = 2 * (w & 1) + n;
              { const int j = 16 * jb + fr; const float ghj = gh[j];
#pragma unroll
                for (int r = 0; r < 4; ++r) { const int i = 16 * ib + 4 * fq + r; if (j < i) mpc[i * (i - 1) / 2 + j] = bt[i] * am[n][r] * __expf(gh[i] - ghj); } }
              { const int i = 16 * ib + fr, j0 = 16 * jb + 4 * fq; const float ghi = gh[i]; float v[4];
#pragma unroll
                for (int r = 0; r < 4; ++r) v[r] = (j0 + r <= i) ? aq[n][r] * __expf(ghi - gh[j0 + r]) : 0.f;
                *(u32x2*)(QKM + i * 64 + j0) = (u32x2){cvt_pk_bf16(v[0], v[1]), cvt_pk_bf16(v[2], v[3])}; } } }
        lds_barrier();
    }
    { const LAS float* mw = mp + w * 2048; float Tr[64];
      float* TG = (float*)(p.ws + WS_GT) + (size_t)(item0 + w) * 4096;
#pragma unroll
      for (int i = 0; i < 64; ++i) { float acc = (lane == i) ? 1.f : 0.f;
#pragma unroll
          for (int j = 0; j < i; ++j) acc -= mw[i * (i - 1) / 2 + j] * Tr[j];
          Tr[i] = acc; TG[i * 64 + lane] = acc; } }
    __syncthreads();
    LAS bf16_t* T_s = (LAS bf16_t*)lds; LAS bf16_t* Tl_s = T_s + 64 * 72; LAS bf16_t* BVT_s = Tl_s + 64 * 72; LAS bf16_t* BVTl_s = BVT_s + 128 * 72; LAS bf16_t* KGT_s = BVTl_s + 128 * 72; LAS bf16_t* KGTl_s = KGT_s + 128 * 72;
    const int col = tid & 127, tq = tid >> 7;
    f32x4 tn0, tn1; float vcn[16], kcn[16];
    auto load3 = [&](int cc) __attribute__((always_inline)) {
        const float* tr = (const float*)(p.ws + WS_GT) + (size_t)(item0 + cc) * 4096 + t * 64 + pc * 8; tn0 = *(const f32x4*)tr; tn1 = *(const f32x4*)(tr + 4);
#pragma unroll
        for (int i = 0; i < 16; ++i) { const size_t row = (size_t)(rowg + cc * 64 + tq * 16 + i); vcn[i] = VB[row * D + h * 128 + col]; kcn[i] = KB[row * D + h * 128 + col]; }
    };
    load3(0);
    for (int cc = 0; cc < 8; ++cc) {
        const int item = item0 + cc;
        const LAS float* gh = gh_all + cc * 64; const LAS float* bt = bt_all + cc * 64;
        { const f32x4 t0 = tn0, t1 = tn1;
          const u32 h0 = cvt_pk_bf16(t0[0], t0[1]), h1 = cvt_pk_bf16(t0[2], t0[3]), h2 = cvt_pk_bf16(t1[0], t1[1]), h3 = cvt_pk_bf16(t1[2], t1[3]);
          *(LAS u32x4*)(T_s + t * 72 + pc * 8) = (u32x4){h0, h1, h2, h3};
          *(LAS u32x4*)(Tl_s + t * 72 + pc * 8) = (u32x4){cvt_pk_bf16(t0[0] - bf_lo(h0), t0[1] - bf_hi(h0)), cvt_pk_bf16(t0[2] - bf_lo(h1), t0[3] - bf_hi(h1)), cvt_pk_bf16(t1[0] - bf_lo(h2), t1[1] - bf_hi(h2)), cvt_pk_bf16(t1[2] - bf_lo(h3), t1[3] - bf_hi(h3))}; }
        { u32 vh[8], vl[8], kh[8], kl[8];
#pragma unroll
          for (int i = 0; i < 8; ++i) { const int ta = tq * 16 + 2 * i; const float b0 = bt[ta], b1 = bt[ta + 1];
              const float xv0 = vcn[2 * i] * b0, xv1 = vcn[2 * i + 1] * b1, xk0 = kcn[2 * i] * b0 * __expf(gh[ta]), xk1 = kcn[2 * i + 1] * b1 * __expf(gh[ta + 1]);
              vh[i] = cvt_pk_bf16(xv0, xv1); vl[i] = cvt_pk_bf16(xv0 - bf_lo(vh[i]), xv1 - bf_hi(vh[i])); kh[i] = cvt_pk_bf16(xk0, xk1); kl[i] = cvt_pk_bf16(xk0 - bf_lo(kh[i]), xk1 - bf_hi(kh[i])); }
          const int o = col * 72 + tq * 16;
          *(LAS u32x4*)(BVT_s + o) = (u32x4){vh[0], vh[1], vh[2], vh[3]}; *(LAS u32x4*)(BVT_s + o + 8) = (u32x4){vh[4], vh[5], vh[6], vh[7]};
          *(LAS u32x4*)(BVTl_s + o) = (u32x4){vl[0], vl[1], vl[2], vl[3]}; *(LAS u32x4*)(BVTl_s + o + 8) = (u32x4){vl[4], vl[5], vl[6], vl[7]};
          *(LAS u32x4*)(KGT_s + o) = (u32x4){kh[0], kh[1], kh[2], kh[3]}; *(LAS u32x4*)(KGT_s + o + 8) = (u32x4){kh[4], kh[5], kh[6], kh[7]};
          *(LAS u32x4*)(KGTl_s + o) = (u32x4){kl[0], kl[1], kl[2], kl[3]}; *(LAS u32x4*)(KGTl_s + o + 8) = (u32x4){kl[4], kl[5], kl[6], kl[7]}; }
        lds_barrier();
        load3(cc + 1 < 8 ? cc + 1 : 7);
        { f32x4 au[4], aw[4];
#pragma unroll
          for (int ib = 0; ib < 4; ++ib) { au[ib] = (f32x4){0.f, 0.f, 0.f, 0.f}; aw[ib] = au[ib]; }
#pragma unroll
          for (int kk = 0; kk < 2; ++kk) {
              const int ao = (16 * w + fr) * 72 + kk * 32 + 8 * fq;
              const bf16x8 av = *(const LAS bf16x8*)(BVT_s + ao), avl = *(const LAS bf16x8*)(BVTl_s + ao), ak = *(const LAS bf16x8*)(KGT_s + ao), akl = *(const LAS bf16x8*)(KGTl_s + ao);
#pragma unroll
              for (int ib = 0; ib < 4; ++ib) { const int bo = (16 * ib + fr) * 72 + kk * 32 + 8 * fq;
                  const bf16x8 tb = *(const LAS bf16x8*)(T_s + bo), tl = *(const LAS bf16x8*)(Tl_s + bo);
                  au[ib] = __builtin_amdgcn_mfma_f32_16x16x32_bf16(av, tb, au[ib], 0, 0, 0); au[ib] = __builtin_amdgcn_mfma_f32_16x16x32_bf16(avl, tb, au[ib], 0, 0, 0); au[ib] = __builtin_amdgcn_mfma_f32_16x16x32_bf16(av, tl, au[ib], 0, 0, 0);
                  aw[ib] = __builtin_amdgcn_mfma_f32_16x16x32_bf16(ak, tb, aw[ib], 0, 0, 0); aw[ib] = __builtin_amdgcn_mfma_f32_16x16x32_bf16(akl, tb, aw[ib], 0, 0, 0); aw[ib] = __builtin_amdgcn_mfma_f32_16x16x32_bf16(ak, tl, aw[ib], 0, 0, 0); } }
          float* U = (float*)(p.ws + WS_GU) + (size_t)item * 8192; bf16_t* W = (bf16_t*)(p.ws + WS_GW) + (size_t)item * 8192;
#pragma unroll
          for (int ib = 0; ib < 4; ++ib) { const int i = 16 * ib + fr, d0 = 16 * w + 4 * fq;
              *(f32x4*)(U + i * 128 + d0) = au[ib];
              *(u32x2*)(W + i * 128 + d0) = (u32x2){cvt_pk_bf16(aw[ib][0], aw[ib][1]), cvt_pk_bf16(aw[ib][2], aw[ib][3])}; } }
        lds_barrier();
    }
    __syncthreads();
}
__device__ __forceinline__ void gdn_chunk_item(const Params& p, LAS unsigned char* lds, int bh, int sl) {
    const int tid = otid(), w = tid >> 6, lane = tid & 63, fr = lane & 15, fq = lane >> 4;
    const int b = bh >> 4, h = bh & 15, row0 = b * SEQ;
    LAS bf16_t* w_s = (LAS bf16_t*)lds; LAS bf16_t* qg_s = w_s + 64 * 136; LAS bf16_t* ke_s = qg_s + 64 * 136; LAS bf16_t* qkm_s = ke_s + 128 * 72; LAS bf16_t* ST_s = qkm_s + 64 * 72; LAS bf16_t* vnT_s = ST_s + 32 * 136;
    const bf16_t* W = (const bf16_t*)(p.ws + WS_GW) + (size_t)bh * 32 * 8192; const bf16_t* QG = (const bf16_t*)(p.ws + WS_GQG) + (size_t)bh * 32 * 8192;
    const bf16_t* KE = (const bf16_t*)(p.ws + WS_GKE) + (size_t)bh * 32 * 8192; const bf16_t* QKM = (const bf16_t*)(p.ws + WS_GQKM) + (size_t)bh * 32 * 4096;
    const float* U = (const float*)(p.ws + WS_GU) + (size_t)bh * 32 * 8192; const float* EG = (const float*)(p.ws + WS_GEG) + bh * 32;
    float* OB = (float*)(p.ws + WS_OB);
    for (int e = tid; e < 32 * 136 / 8; e += 512) ((LAS u32x4*)ST_s)[e] = (u32x4){0, 0, 0, 0};
    f32x4 S[2]; S[0] = (f32x4){0.f, 0.f, 0.f, 0.f}; S[1] = S[0];
    const int tb = w >> 1, db = w & 1;
    struct Regs { u32x4 rw[2], rq[2], rk[2], rm; f32x4 ru; float reg; };
    auto load_regs = [&](Regs& R, int c) {
#pragma unroll
        for (int i = 0; i < 2; ++i) { const int e = tid + 512 * i; R.rw[i] = *(const u32x4*)(W + (size_t)c * 8192 + e * 8); R.rq[i] = *(const u32x4*)(QG + (size_t)c * 8192 + e * 8); R.rk[i] = *(const u32x4*)(KE + (size_t)c * 8192 + e * 8); }
        R.rm = *(const u32x4*)(QKM + (size_t)c * 4096 + tid * 8);
#pragma unroll
        for (int r = 0; r < 4; ++r) R.ru[r] = U[(size_t)c * 8192 + (16 * tb + 4 * fq + r) * 128 + sl * 32 + 16 * db + fr];
        R.reg = EG[c];
    };
    auto step = [&](Regs& R, int c) {
#pragma unroll
        for (int i = 0; i < 2; ++i) { const int e = tid + 512 * i;
            *(LAS u32x4*)(w_s + (e >> 4) * 136 + (e & 15) * 8) = R.rw[i]; *(LAS u32x4*)(qg_s + (e >> 4) * 136 + (e & 15) * 8) = R.rq[i];
            *(LAS u32x4*)(ke_s + (e >> 3) * 72 + (e & 7) * 8) = R.rk[i]; }
        *(LAS u32x4*)(qkm_s + (tid >> 3) * 72 + (tid & 7) * 8) = R.rm;
        const f32x4 ucur = R.ru; const float eg = R.reg;
        lds_barrier();
        load_regs(R, c + 2 < 32 ? c + 2 : 31);
        { f32x4 acc = (f32x4){0.f, 0.f, 0.f, 0.f};
#pragma unroll
          for (int kk = 0; kk < 4; ++kk) acc = __builtin_amdgcn_mfma_f32_16x16x32_bf16(*(const LAS bf16x8*)(w_s + (16 * tb + fr) * 136 + kk * 32 + 8 * fq), *(const LAS bf16x8*)(ST_s + (16 * db + fr) * 136 + kk * 32 + 8 * fq), acc, 0, 0, 0);
          const f32x4 vn = ucur - acc;
          *(LAS u32x2*)(vnT_s + (16 * db + fr) * 72 + 16 * tb + 4 * fq) = (u32x2){cvt_pk_bf16(vn[0], vn[1]), cvt_pk_bf16(vn[2], vn[3])}; }
        lds_barrier();
        { f32x4 acc = (f32x4){0.f, 0.f, 0.f, 0.f};
#pragma unroll
          for (int kk = 0; kk < 4; ++kk) acc = __builtin_amdgcn_mfma_f32_16x16x32_bf16(*(const LAS bf16x8*)(qg_s + (16 * tb + fr) * 136 + kk * 32 + 8 * fq), *(const LAS bf16x8*)(ST_s + (16 * db + fr) * 136 + kk * 32 + 8 * fq), acc, 0, 0, 0);
#pragma unroll
          for (int kk = 0; kk < 2; ++kk) acc = __builtin_amdgcn_mfma_f32_16x16x32_bf16(*(const LAS bf16x8*)(qkm_s + (16 * tb + fr) * 72 + kk * 32 + 8 * fq), *(const LAS bf16x8*)(vnT_s + (16 * db + fr) * 72 + kk * 32 + 8 * fq), acc, 0, 0, 0);
#pragma unroll
          for (int r = 0; r < 4; ++r) OB[(size_t)(row0 + c * 64 + 16 * tb + 4 * fq + r) * D + h * 128 + sl * 32 + 16 * db + fr] = acc[r]; }
#pragma unroll
        for (int n = 0; n < 2; ++n) { S[n] *= eg;
#pragma unroll
            for (int kk = 0; kk < 2; ++kk) S[n] = __builtin_amdgcn_mfma_f32_16x16x32_bf16(*(const LAS bf16x8*)(ke_s + (16 * w + fr) * 72 + kk * 32 + 8 * fq), *(const LAS bf16x8*)(vnT_s + (16 * n + fr) * 72 + kk * 32 + 8 * fq), S[n], 0, 0, 0); }
        lds_barrier();
#pragma unroll
        for (int n = 0; n < 2; ++n) *(LAS u32x2*)(ST_s + (16 * n + fr) * 136 + 16 * w + 4 * fq) = (u32x2){cvt_pk_bf16(S[n][0], S[n][1]), cvt_pk_bf16(S[n][2], S[n][3])};
    };
    Regs RA, RB;
    load_regs(RA, 0); load_regs(RB, 1);
    for (int c = 0; c < 32; c += 2) { step(RA, c); step(RB, c + 1); }
    float* so = p.out + O_GDN_P + (size_t)bh * 16384;
#pragma unroll
    for (int n = 0; n < 2; ++n)
#pragma unroll
        for (int r = 0; r < 4; ++r) so[(size_t)(16 * w + 4 * fq + r) * 128 + sl * 32 + 16 * n + fr] = S[n][r];
    __syncthreads();
}

__device__ __forceinline__ void gla_chunk_item(const Params& p, LAS unsigned char* lds, int bh, int sl) {
    const int tid = otid(), w = tid >> 6, lane = tid & 63, fr = lane & 15, fq = lane >> 4;
    const int b = bh >> 2, h = bh & 3, row0 = b * SEQ;
    LAS bf16_t* qd_s = (LAS bf16_t*)lds; LAS bf16_t* keT_s = qd_s + 64 * 264; LAS bf16_t* att_s = keT_s + 256 * 72; LAS bf16_t* vT_s = att_s + 64 * 72; LAS bf16_t* ST_s = vT_s + 64 * 72;
    LAS float* E_s = (LAS float*)(ST_s + 64 * 264);
    const bf16_t* P = (const bf16_t*)(p.ws + WS_P);
    const bf16_t* QD = (const bf16_t*)(p.ws + WS_QD) + (size_t)bh * 32 * 16384; const bf16_t* KET = (const bf16_t*)(p.ws + WS_KET) + (size_t)bh * 32 * 16384;
    const bf16_t* ATT = (const bf16_t*)(p.ws + WS_ATT) + (size_t)bh * 32 * 4096; const float* Eg = (const float*)(p.ws + WS_E) + (size_t)bh * 32 * 256;
    float* OA = (float*)(p.ws + WS_OA);
    for (int e = tid; e < 64 * 264 / 8; e += 512) ((LAS u32x4*)ST_s)[e] = (u32x4){0, 0, 0, 0};
    f32x4 S[2][4];
#pragma unroll
    for (int a = 0; a < 2; ++a)
#pragma unroll
        for (int n = 0; n < 4; ++n) S[a][n] = (f32x4){0.f, 0.f, 0.f, 0.f};
    u32x4 rqd[4], rke[4], ratt, rv; f32x4 rE;
    auto load_regs = [&](int c) {
#pragma unroll
        for (int i = 0; i < 4; ++i) { const int e = tid + 512 * i; rqd[i] = *(const u32x4*)(QD + (size_t)c * 16384 + e * 8); rke[i] = *(const u32x4*)(KET + (size_t)c * 16384 + e * 8); }
        ratt = *(const u32x4*)(ATT + (size_t)c * 4096 + tid * 8);
        rv = *(const u32x4*)(P + (size_t)(row0 + c * 64 + (tid >> 3)) * N1 + C_VA + h * 512 + sl * 64 + (tid & 7) * 8);
        if (tid < 64) rE = *(const f32x4*)(Eg + c * 256 + tid * 4);
    };
    load_regs(0);
    const int ib = w >> 1, dv2 = (w & 1) * 2;
    for (int c = 0; c < 32; ++c) {
#pragma unroll
        for (int i = 0; i < 4; ++i) { const int e = tid + 512 * i;
            *(LAS u32x4*)(qd_s + (e >> 5) * 264 + (e & 31) * 8) = rqd[i];
            *(LAS u32x4*)(keT_s + (e >> 3) * 72 + (e & 7) * 8) = rke[i]; }
        *(LAS u32x4*)(att_s + (tid >> 3) * 72 + (tid & 7) * 8) = ratt;
        { const int t = tid >> 3, d0 = (tid & 7) * 8;
          vT_s[(d0 + 0) * 72 + t] = (bf16_t)(rv.x & 0xffffu); vT_s[(d0 + 1) * 72 + t] = (bf16_t)(rv.x >> 16);
          vT_s[(d0 + 2) * 72 + t] = (bf16_t)(rv.y & 0xffffu); vT_s[(d0 + 3) * 72 + t] = (bf16_t)(rv.y >> 16);
          vT_s[(d0 + 4) * 72 + t] = (bf16_t)(rv.z & 0xffffu); vT_s[(d0 + 5) * 72 + t] = (bf16_t)(rv.z >> 16);
          vT_s[(d0 + 6) * 72 + t] = (bf16_t)(rv.w & 0xffffu); vT_s[(d0 + 7) * 72 + t] = (bf16_t)(rv.w >> 16); }
        if (tid < 64) *(LAS f32x4*)(E_s + tid * 4) = rE;
        lds_barrier();
        load_regs(c + 1 < 32 ? c + 1 : 31);
        { f32x4 acc[2]; acc[0] = (f32x4){0.f, 0.f, 0.f, 0.f}; acc[1] = acc[0];
#pragma unroll
          for (int kk = 0; kk < 2; ++kk) { const bf16x8 a = *(const LAS bf16x8*)(att_s + (16 * ib + fr) * 72 + kk * 32 + 8 * fq);
#pragma unroll
              for (int n = 0; n < 2; ++n) { const bf16x8 bb = *(const LAS bf16x8*)(vT_s + (16 * (dv2 + n) + fr) * 72 + kk * 32 + 8 * fq); acc[n] = __builtin_amdgcn_mfma_f32_16x16x32_bf16(a, bb, acc[n], 0, 0, 0); } }
#pragma unroll
          for (int kk = 0; kk < 8; ++kk) { const bf16x8 a = *(const LAS bf16x8*)(qd_s + (16 * ib + fr) * 264 + kk * 32 + 8 * fq);
#pragma unroll
              for (int n = 0; n < 2; ++n) { const bf16x8 bb = *(const LAS bf16x8*)(ST_s + (16 * (dv2 + n) + fr) * 264 + kk * 32 + 8 * fq); acc[n] = __builtin_amdgcn_mfma_f32_16x16x32_bf16(a, bb, acc[n], 0, 0, 0); } }
#pragma unroll
          for (int n = 0; n < 2; ++n)
#pragma unroll
              for (int r = 0; r < 4; ++r) OA[(size_t)(row0 + c * 64 + 16 * ib + 4 * fq + r) * D + h * 512 + sl * 64 + 16 * (dv2 + n) + fr] = acc[n][r] * 0.0625f; }
#pragma unroll
        for (int a = 0; a < 2; ++a) { const f32x4 e4 = *(const LAS f32x4*)(E_s + 16 * (2 * w + a) + 4 * fq);
#pragma unroll
            for (int n = 0; n < 4; ++n) S[a][n] *= e4; }
#pragma unroll
        for (int kk = 0; kk < 2; ++kk) {
            bf16x8 bv[4];
#pragma unroll
            for (int n = 0; n < 4; ++n) bv[n] = *(const LAS bf16x8*)(vT_s + (16 * n + fr) * 72 + kk * 32 + 8 * fq);
#pragma unroll
            for (int a = 0; a < 2; ++a) { const bf16x8 ak = *(const LAS bf16x8*)(keT_s + (16 * (2 * w + a) + fr) * 72 + kk * 32 + 8 * fq);
#pragma unroll
                for (int n = 0; n < 4; ++n) S[a][n] = __builtin_amdgcn_mfma_f32_16x16x32_bf16(ak, bv[n], S[a][n], 0, 0, 0); } }
        lds_barrier();
#pragma unroll
        for (int a = 0; a < 2; ++a)
#pragma unroll
            for (int n = 0; n < 4; ++n) *(LAS u32x2*)(ST_s + (16 * n + fr) * 264 + 16 * (2 * w + a) + 4 * fq) = (u32x2){cvt_pk_bf16(S[a][n][0], S[a][n][1]), cvt_pk_bf16(S[a][n][2], S[a][n][3])};
    }
    float* so = p.out + O_GLA_P + (size_t)bh * 131072;
#pragma unroll
    for (int a = 0; a < 2; ++a)
#pragma unroll
        for (int n = 0; n < 4; ++n)
#pragma unroll
            for (int r = 0; r < 4; ++r) so[(size_t)(16 * (2 * w + a) + 4 * fq + r) * 512 + sl * 64 + 16 * n + fr] = S[a][n][r];
    __syncthreads();
}
__device__ __forceinline__ void phase3(const Params& p, LAS unsigned char* lds) {
    constexpr int nA = 256, nB = 128, nC = 512, nD = 2048;
    for (int it = blockIdx.x; it < nA + nB; it += gridDim.x) {
        int r = it;
        if (r < nA) { gdn_prep_item(p, lds, r >> 2, r & 3); continue; } r -= nA;
        { const int xcd = r & 7, idx = r >> 3; gla_chunk_item(p, lds, xcd * 2 + (idx >> 3), idx & 7); }
    }
    unsigned* ctr = (unsigned*)(p.ws + WS_BAR) + 64;
    volatile LAS unsigned* slot = (volatile LAS unsigned*)(lds + 131072 + 16);
    unsigned nxt = 0u;
    if (threadIdx.x == 0) nxt = __hip_atomic_fetch_add(ctr, 1u, __ATOMIC_RELAXED, __HIP_MEMORY_SCOPE_AGENT);
    for (int k = 0;; ++k) {
        if (threadIdx.x == 0) slot[k & 1] = nxt;
        __syncthreads();
        const int r = (int)slot[k & 1];
        if (r >= nC + nD) break;
        if (threadIdx.x == 0) nxt = __hip_atomic_fetch_add(ctr, 1u, __ATOMIC_RELAXED, __HIP_MEMORY_SCOPE_AGENT);
        if (r < nC) gla_sample_item(p, lds, r >> 2, r & 3); else gdn_sample_item(p, lds, (r - nC) >> 4, (r - nC) & 15);
    }
}
__device__ __forceinline__ void phase3b(const Params& p, LAS unsigned char* lds) {
    for (int it = blockIdx.x; it < 256; it += gridDim.x) { const int xcd = it & 7, idx = it >> 3; gdn_chunk_item(p, lds, xcd * 8 + (idx >> 2), idx & 3); }
}

__device__ __forceinline__ void phase4(const Params& p) {
    const int tid_ = otid(), lane = tid_ & 63, wave = tid_ >> 6;
    const int gw = blockIdx.x * 8 + wave, NGW = gridDim.x * 8;
    const bf16_t* P = (const bf16_t*)(p.ws + WS_P);
    const float* OA = (const float*)(p.ws + WS_OA); const float* OB = (const float*)(p.ws + WS_OB);
    bf16_t* OAN = (bf16_t*)(p.ws + WS_OAN); bf16_t* OBN = (bf16_t*)(p.ws + WS_OBN);
    for (int it = gw; it < (NT / 4) * 8; it += NGW) {
        const int tq = it >> 3, sub = it & 7;
        const bool isA = sub < 4;
        const int c0 = (isA ? sub : sub - 4) * 512 + lane * 8;
        const float* src = (isA ? OA : OB) + c0; bf16_t* dst = (isA ? OAN : OBN) + c0;
        const float* gn = isA ? p.gla_norm_g + lane * 8 : p.gdn_norm_g + (lane & 15) * 8;
        const f32x4 g0 = *(const f32x4*)gn, g1 = *(const f32x4*)(gn + 4);
        f32x4 a[4], b[4]; u32x4 gw4[4];
#pragma unroll
        for (int u = 0; u < 4; ++u) { const size_t tok = (size_t)(tq * 4 + u);
            a[u] = *(const f32x4*)(src + tok * D); b[u] = *(const f32x4*)(src + tok * D + 4);
            gw4[u] = *(const u32x4*)(P + tok * N1 + (isA ? C_GA : C_GB) + c0); }
#pragma unroll
        for (int u = 0; u < 4; ++u) { const size_t tok = (size_t)(tq * 4 + u);
            float ss = (a[u][0] * a[u][0] + a[u][1] * a[u][1]) + (a[u][2] * a[u][2] + a[u][3] * a[u][3]) + (b[u][0] * b[u][0] + b[u][1] * b[u][1]) + (b[u][2] * b[u][2] + b[u][3] * b[u][3]);
            ss += dpp<0xB1>(ss); ss += dpp<0x4E>(ss); ss += dpp<0x141>(ss); ss += dpp<0x140>(ss);
            float inv;
            if (isA) inv = rsqrtf(xrow16_sum(ss) * (1.0f / 512.0f) + EPS); else inv = rsqrtf(ss * (1.0f / 128.0f) + EPS);
            u32x4 o;
            o.x = cvt_pk_bf16(a[u][0] * inv * g0[0] * siluf_(bf_lo(gw4[u].x)), a[u][1] * inv * g0[1] * siluf_(bf_hi(gw4[u].x)));
            o.y = cvt_pk_bf16(a[u][2] * inv * g0[2] * siluf_(bf_lo(gw4[u].y)), a[u][3] * inv * g0[3] * siluf_(bf_hi(gw4[u].y)));
            o.z = cvt_pk_bf16(b[u][0] * inv * g1[0] * siluf_(bf_lo(gw4[u].z)), b[u][1] * inv * g1[1] * siluf_(bf_hi(gw4[u].z)));
            o.w = cvt_pk_bf16(b[u][2] * inv * g1[2] * siluf_(bf_lo(gw4[u].w)), b[u][3] * inv * g1[3] * siluf_(bf_hi(gw4[u].w)));
            *(u32x4*)(dst + tok * D) = o; }
    }
}

__device__ __forceinline__ void phase7(const Params& p) {
    const int tid_ = otid(), lane = tid_ & 63, wave = tid_ >> 6;
    const int gw = blockIdx.x * 8 + wave, NGW = gridDim.x * 8;
    for (int row = gw; row < NT; row += NGW) {
        float* xr = p.out + O_Y + (size_t)row * D;
        f32x4 v[8]; float ss = 0.f;
#pragma unroll
        for (int j = 0; j < 8; ++j) { v[j] = *(const f32x4*)(xr + j * 256 + lane * 4); ss += (v[j][0] * v[j][0] + v[j][1] * v[j][1]) + (v[j][2] * v[j][2] + v[j][3] * v[j][3]); }
        const float inv = rsqrtf(wave_sum_fast(ss) * (1.0f / D) + EPS);
#pragma unroll
        for (int j = 0; j < 8; ++j) { const f32x4 g = *(const f32x4*)(p.final_norm_g + j * 256 + lane * 4); __builtin_nontemporal_store(v[j] * inv * g, (f32x4*)(xr + j * 256 + lane * 4)); }
    }
}

#ifndef PH_LO
#define PH_LO 0
#endif
#ifndef PH_HI
#define PH_HI 8
#endif
#ifndef GEMM_SP2
#define GEMM_SP2 true
#endif
#ifndef GEMM_ALIGN
#define GEMM_ALIGN true
#endif
extern __shared__ __attribute__((aligned(16))) unsigned char shm[];
__global__ void __launch_bounds__(512, 2) fwd_megakernel(Params p) {
    cg::grid_group grid = cg::this_grid();
    LAS unsigned char* lds = (LAS unsigned char*)shm;
    const int G = gridDim.x, c = blockIdx.x;
    unsigned* bar = (unsigned*)(p.ws + WS_BAR);
    volatile LAS unsigned* st = (volatile LAS unsigned*)(lds + 131072);
    if (threadIdx.x < 2) st[threadIdx.x] = 0u;
    if (blockIdx.x == 0) for (int i = threadIdx.x; i < 8192; i += 512) bar[i] = 0u;
    __syncthreads();
    grid.sync();
    const XcdBarrier xb = xcd_barrier_post(bar, st);
    phase0(p, lds);
    xcd_barrier(xb);
    { pg8::Gemm g; g.A0 = g.A1 = (const bf16_t*)(p.ws + WS_H); g.Bt0 = g.Bt1 = (const bf16_t*)(p.ws + WS_W1T); g.M = NT; g.N = N1; g.K = D;
      pg8::StaticOrder S; S.init(NT, N1, G, c); pg8::EpiP E; E.O = (bf16_t*)(p.ws + WS_P);
      pg8::gemm_phase<GEMM_SP2, GEMM_ALIGN>(lds, g, S, E); }
    xcd_barrier(xb);
    phase2(p, lds);
    xcd_barrier(xb);
    phase3(p, lds);
    xcd_barrier(xb);
    phase3b(p, lds);
    xcd_barrier(xb);
    phase4(p);
    xcd_barrier(xb);
    { pg8::Gemm g; g.A0 = (const bf16_t*)(p.ws + WS_OAN); g.A1 = (const bf16_t*)(p.ws + WS_OBN); g.Bt0 = (const bf16_t*)(p.ws + WS_WAT); g.Bt1 = (const bf16_t*)(p.ws + WS_WBT); g.M = NT; g.N = D; g.K = D;
      pg8::PairOrder S; S.init(NT, D, G, c); pg8::EpiGate E; E.P = (const bf16_t*)(p.ws + WS_P); E.YT = (float*)(p.ws + WS_YT); E.MRG = (bf16_t*)(p.ws + WS_MRG); E.flags = (unsigned*)(p.ws + WS_BAR) + 4096;
      pg8::gemm_phase<GEMM_SP2, GEMM_ALIGN>(lds, g, S, E); }
    xcd_barrier(xb);
    { pg8::Gemm g; g.A0 = g.A1 = (const bf16_t*)(p.ws + WS_MRG); g.Bt0 = g.Bt1 = (const bf16_t*)(p.ws + WS_WOT); g.M = NT; g.N = D; g.K = D;
      pg8::StaticOrder S; S.init(NT, D, G, c); pg8::EpiOut E; E.xp = p.x_prompt; E.xs = p.x_sample; E.O = p.out + O_Y;
      pg8::gemm_phase<GEMM_SP2, GEMM_ALIGN>(lds, g, S, E); }
    xcd_barrier(xb);
    phase7(p);
}

extern "C" void kernel_launch(void* const* d_in, const int* in_sizes, int n_in, void* d_out, int out_size, void* d_ws, size_t ws_size, hipStream_t stream) {
    static int grid_blocks = 0;
    if (grid_blocks == 0) {
        if (n_in != 18 || ws_size < WS_END) { fprintf(stderr, "kernel_launch: unexpected n_in %d / ws_size %zu (need %zu)\n", n_in, ws_size, (size_t)WS_END); grid_blocks = -1; return; }
        int dev = 0, cus = 0, per_cu = 0;
        (void)hipGetDevice(&dev);
        (void)hipDeviceGetAttribute(&cus, hipDeviceAttributeMultiprocessorCount, dev);
        if (hipFuncSetAttribute((const void*)fwd_megakernel, hipFuncAttributeMaxDynamicSharedMemorySize, LDS_BYTES) != hipSuccess) fprintf(stderr, "kernel_launch: hipFuncSetAttribute failed\n");
        (void)hipOccupancyMaxActiveBlocksPerMultiprocessor(&per_cu, (const void*)fwd_megakernel, 512, LDS_BYTES);
        if (per_cu < 1) { fprintf(stderr, "kernel_launch: occupancy query says %d blocks per CU\n", per_cu); per_cu = 1; }
        if (per_cu > 1) per_cu = 1;
        grid_blocks = cus * per_cu;
        (void)hipGetLastError();
    }
    if (grid_blocks < 0) return;
    Params p{};
    p.x_prompt = (const float*)d_in[0]; p.x_sample = (const float*)d_in[1]; p.state_gla = (const float*)d_in[2]; p.state_gdn = (const float*)d_in[3]; p.state_conv = (const float*)d_in[4];
    p.ln_in_g = (const float*)d_in[5]; p.w_in = (const float*)d_in[6]; p.w_alpha2 = (const float*)d_in[7]; p.b_alpha = (const float*)d_in[8]; p.conv_w = (const float*)d_in[9];
    p.a_log = (const float*)d_in[10]; p.dt_bias = (const float*)d_in[11]; p.gla_norm_g = (const float*)d_in[12]; p.gdn_norm_g = (const float*)d_in[13];
    p.w_br_a = (const float*)d_in[14]; p.w_br_b = (const float*)d_in[15]; p.w_out = (const float*)d_in[16]; p.final_norm_g = (const float*)d_in[17];
    p.out = (float*)d_out; p.ws = (unsigned char*)d_ws;
    void* args[] = {&p};
    hipError_t e = hipLaunchCooperativeKernel((const void*)fwd_megakernel, dim3(grid_blocks), dim3(512), args, LDS_BYTES, stream);
    if (e != hipSuccess) fprintf(stderr, "cooperative launch failed: %s (grid %d)\n", hipGetErrorString(e), grid_blocks);
}
```
